# Optimizing an MI355X kernel written in HIP

```python
import math, functools
import jax, jax.numpy as jnp
from jax import lax
import numpy as np

D_MODEL = 1024
BATCH = 32
SEQ = 256
DEPTH = 2
DEC_BATCH = 8
DEC_SEQ = 4096
PAST_LEN = 256

GRID_W = 64
HEAD_DIM = 64
BLOCK = 128
ROPE_BASE = 10000.0
N_AB = (DEPTH + 1) // 2
N_CD = DEPTH // 2
A_HEADS = (D_MODEL // 2) // HEAD_DIM
A_KV_HEADS = A_HEADS // 4
A_REP = A_HEADS // A_KV_HEADS
WINDOW = 128
B_HEADS = (D_MODEL // 2) // HEAD_DIM
B_DK = HEAD_DIM
B_DV = HEAD_DIM
RET_CHUNK = 128
C_WIDTH = D_MODEL // 2
C_GROUP = 16
C_GROUPS = C_WIDTH // C_GROUP
C_STATE = 64
D_QK = HEAD_DIM
D_V = 2 * HEAD_DIM
D_HEADS = (D_MODEL // 2) // D_V
FFN_HIDDEN = -(-8 * D_MODEL // (3 * 256)) * 256
AB_SPLITS = (A_HEADS * HEAD_DIM, A_KV_HEADS * HEAD_DIM, A_KV_HEADS * HEAD_DIM,
             B_HEADS * B_DK, B_HEADS * B_DK, B_HEADS * B_DV, B_HEADS * B_DV)
AB_COLS = sum(AB_SPLITS)
AB_OUT = A_HEADS * HEAD_DIM + B_HEADS * B_DV
CD_SPLITS = (C_WIDTH, D_HEADS * 2 * D_QK, D_HEADS * 2 * D_QK, D_HEADS * D_V)
CD_COLS = sum(CD_SPLITS)
CD_OUT = C_WIDTH + D_HEADS * D_V
NEG_INF = -1e30

kernel_name = 'hybrid_diffusion_prefix_trunk_step'


def rms_norm(x, g, eps=1e-6):
    xf = x.astype(jnp.float32)
    y = xf * lax.rsqrt(jnp.mean(xf * xf, axis=-1, keepdims=True) + eps)
    return (y * g.astype(jnp.float32)).astype(x.dtype)


def split_cols(p, sizes):
    return jnp.split(p, np.cumsum(sizes)[:-1].tolist(), axis=-1)


def ada_modulation(cond, w, b):
    m = jax.nn.silu(cond) @ w + b
    return jnp.split(m[..., None, :], 6, axis=-1)


def swiglu(h, w1, w3, w2):
    return (jax.nn.silu(h @ w1) * (h @ w3)) @ w2


def axial_rope(n_tok, dim):
    rows = n_tok // GRID_W
    r = jnp.repeat(jnp.arange(rows, dtype=jnp.float32), GRID_W)
    col = jnp.tile(jnp.arange(GRID_W, dtype=jnp.float32), rows)
    n_freq = dim // 4
    inv = ROPE_BASE ** (-jnp.arange(n_freq, dtype=jnp.float32) / n_freq)
    ang = jnp.concatenate([r[:, None] * inv, col[:, None] * inv], axis=-1)
    return jnp.cos(ang), jnp.sin(ang)


def apply_rope(x, rope):
    cos, sin = rope
    half = x.shape[-1] // 2
    shp = (cos.shape[0],) + (1,) * (x.ndim - 3) + (half,)
    cos = cos.reshape(shp)
    sin = sin.reshape(shp)
    xf = x.astype(jnp.float32)
    x1, x2 = xf[..., :half], xf[..., half:]
    return jnp.concatenate([x1 * cos - x2 * sin, x2 * cos + x1 * sin], axis=-1).astype(x.dtype)


def over_query_blocks(fn, q):
    nb = q.shape[1] // BLOCK
    def one(bi):
        return fn(bi, lax.dynamic_slice_in_dim(q, bi * BLOCK, BLOCK, axis=1))
    out = lax.map(one, jnp.arange(nb))
    out = jnp.moveaxis(out, 0, 1)
    return out.reshape(out.shape[:1] + (nb * BLOCK,) + out.shape[3:])


def sink_attend(q, k, v, mask, sink):
    s = jnp.einsum('bqgrd,bkgd->bgrqk', q, k, preferred_element_type=jnp.float32) * (HEAD_DIM ** -0.5)
    if mask is not None:
        s = jnp.where(mask, s, NEG_INF)
    sk = sink.astype(jnp.float32)[None, :, :, None, None]
    m = jnp.maximum(jnp.max(s, axis=-1, keepdims=True), sk)
    p = jnp.exp(s - m)
    p = p / (jnp.sum(p, axis=-1, keepdims=True) + jnp.exp(sk - m))
    return jnp.einsum('bgrqk,bkgd->bqgrd', p.astype(v.dtype), v)


def window_attn_latent(q, k, v, ck, cv, sink):
    T = q.shape[1]
    Tc = ck.shape[1]
    span = BLOCK + 2 * WINDOW
    pad = ((0, 0), (WINDOW, WINDOW), (0, 0), (0, 0))
    kp = jnp.pad(k, pad)
    vp = jnp.pad(v, pad)
    def block(bi, qb):
        q0 = bi * BLOCK
        kb = lax.dynamic_slice_in_dim(kp, q0, span, axis=1)
        vb = lax.dynamic_slice_in_dim(vp, q0, span, axis=1)
        qpos = q0 + jnp.arange(BLOCK)
        kpos = q0 - WINDOW + jnp.arange(span)
        band = ((jnp.abs(qpos[:, None] - kpos[None, :]) <= WINDOW)
                & (kpos >= 0)[None, :] & (kpos < T)[None, :])
        mask = jnp.concatenate([jnp.ones((BLOCK, Tc), dtype=bool), band], axis=1)
        return sink_attend(qb, jnp.concatenate([ck, kb], axis=1),
                           jnp.concatenate([cv, vb], axis=1), mask, sink)
    return over_query_blocks(block, q)


def diff_attend(q, k, v, lam):
    s = jnp.einsum('bqhcd,bkhcd->bhcqk', q, k, preferred_element_type=jnp.float32) * (D_QK ** -0.5)
    p = jax.nn.softmax(s, axis=-1)
    w = p[:, :, 0] - lam * p[:, :, 1]
    return jnp.einsum('bhqk,bkhe->bqhe', w.astype(v.dtype), v)


def retention_scan(q, k, v, log_g, s0):
    B, T, H, dk = q.shape
    dv = v.shape[-1]
    L = RET_CHUNK
    n = T // L
    lg = log_g.astype(jnp.float32)
    idx = jnp.arange(L, dtype=jnp.float32)
    diff = idx[:, None] - idx[None, :]
    inner_decay = jnp.where(diff >= 0, jnp.exp(lg[:, None, None] * jnp.maximum(diff, 0.0)), 0.0)
    q_decay = jnp.exp(lg[None, :] * (idx[:, None] + 1.0))
    k_decay = jnp.exp(lg[None, :] * (L - 1.0 - idx[:, None]))
    chunk_decay = jnp.exp(lg * L)
    qc = q.reshape(B, n, L, H, dk)
    kc = k.reshape(B, n, L, H, dk)
    vc = v.reshape(B, n, L, H, dv).astype(jnp.float32)
    s = jnp.einsum('bnihd,bnjhd->bnhij', qc, kc, preferred_element_type=jnp.float32) * inner_decay
    inner = jnp.einsum('bnhij,bnjhe->bnihe', s, vc)
    kv = jnp.einsum('bnjhd,bnjhe->nbhde', kc * k_decay[:, :, None], vc)
    def step(state, kv_c):
        return chunk_decay[None, :, None, None] * state + kv_c, state
    s_last, s_prev = lax.scan(step, s0.astype(jnp.float32), kv)
    cross = jnp.einsum('bnihd,nbhde->bnihe', qc * q_decay[:, :, None], s_prev)
    return (inner + cross).reshape(B, T, H, dv), s_last


def retention_bidir(q, k, v, log_g, s0):
    of, sf = retention_scan(q, k, v, log_g[0], s0[:, 0])
    ob, sb = retention_scan(jnp.flip(q, 1), jnp.flip(k, 1), jnp.flip(v, 1), log_g[1], s0[:, 1])
    return of + jnp.flip(ob, 1), jnp.stack([sf, sb], axis=1)


def s5_zoh(lam_re, lam_im, log_dt):
    lr = lam_re.astype(jnp.float32)
    li = lam_im.astype(jnp.float32)
    dt = jnp.exp(log_dt.astype(jnp.float32))[:, None]
    mag = jnp.exp(lr * dt)
    a_re = mag * jnp.cos(li * dt)
    a_im = mag * jnp.sin(li * dt)
    den = lr * lr + li * li
    f_re = ((a_re - 1.0) * lr + a_im * li) / den
    f_im = (a_im * lr - (a_re - 1.0) * li) / den
    return a_re, a_im, f_re, f_im


def s5_combine(e1, e2):
    a1r, a1i, b1r, b1i = e1
    a2r, a2i, b2r, b2i = e2
    return (a1r * a2r - a1i * a2i, a1r * a2i + a1i * a2r,
            a2r * b1r - a2i * b1i + b2r, a2r * b1i + a2i * b1r + b2i)


def s5_bidir(u, lam_re, lam_im, log_dt, b_re, b_im, c_re, c_im, d_skip, h0_re, h0_im):
    B, T, _ = u.shape
    ug = u.reshape(B, T, C_GROUPS, C_GROUP).astype(jnp.float32)
    bu_re = jnp.einsum('btgc,gpc->btgp', ug, b_re.astype(jnp.float32))
    bu_im = jnp.einsum('btgc,gpc->btgp', ug, b_im.astype(jnp.float32))
    hs_re, hs_im, fin_re, fin_im = [], [], [], []
    for dr, reverse in ((0, False), (1, True)):
        a_re, a_im, f_re, f_im = s5_zoh(lam_re[dr], lam_im[dr], log_dt[dr])
        x_re = f_re * bu_re - f_im * bu_im
        x_im = f_re * bu_im + f_im * bu_re
        i_re = h0_re[:, dr].astype(jnp.float32)
        i_im = h0_im[:, dr].astype(jnp.float32)
        first = T - 1 if reverse else 0
        x_re = x_re.at[:, first].add(a_re * i_re - a_im * i_im)
        x_im = x_im.at[:, first].add(a_re * i_im + a_im * i_re)
        ar = jnp.broadcast_to(a_re, (1, T) + a_re.shape)
        ai = jnp.broadcast_to(a_im, (1, T) + a_im.shape)
        _, _, h_re, h_im = lax.associative_scan(s5_combine, (ar, ai, x_re, x_im), reverse=reverse, axis=1)
        last = 0 if reverse else T - 1
        fin_re.append(h_re[:, last])
        fin_im.append(h_im[:, last])
        hs_re.append(h_re)
        hs_im.append(h_im)
    h_re = hs_re[0] + hs_re[1]
    h_im = hs_im[0] + hs_im[1]
    y = (jnp.einsum('btgp,gcp->btgc', h_re, c_re.astype(jnp.float32))
         - jnp.einsum('btgp,gcp->btgc', h_im, c_im.astype(jnp.float32)))
    y = y.reshape(B, T, C_WIDTH) + d_skip.astype(jnp.float32) * u.astype(jnp.float32)
    return y.astype(u.dtype), jnp.stack(fin_re, axis=1), jnp.stack(fin_im, axis=1)


def ab_mixer(h, rope, ctx, w_in, w_out, q_g, k_g, sink, ret_decay, ret_g):
    B, T, _ = h.shape
    qa, ka, va, qb, kb, vb, gb = split_cols(h @ w_in, AB_SPLITS)
    qa = rms_norm(qa.reshape(B, T, A_KV_HEADS, A_REP, HEAD_DIM), q_g)
    ka = rms_norm(ka.reshape(B, T, A_KV_HEADS, HEAD_DIM), k_g)
    va = va.reshape(B, T, A_KV_HEADS, HEAD_DIM)
    qb = qb.reshape(B, T, B_HEADS, B_DK) * (B_DK ** -0.5)
    kb = kb.reshape(B, T, B_HEADS, B_DK)
    vb = vb.reshape(B, T, B_HEADS, B_DV)
    sink_r = sink.reshape(A_KV_HEADS, A_REP)
    log_g = jax.nn.log_sigmoid(ret_decay.astype(jnp.float32))
    if ctx is None:
        oa = over_query_blocks(lambda bi, qblk: sink_attend(qblk, ka, va, None, sink_r), qa)
        s0 = jnp.zeros((B, 2, B_HEADS, B_DK, B_DV), jnp.float32)
        ob, s_ret = retention_bidir(qb, kb, vb, log_g, s0)
        ctx_out = (ka, va, s_ret)
    else:
        ck, cv, s0 = ctx
        oa = window_attn_latent(apply_rope(qa, rope), apply_rope(ka, rope), va, ck, cv, sink_r)
        ob, _ = retention_bidir(qb, kb, vb, log_g, s0)
        ctx_out = None
    ob = rms_norm(ob, ret_g).astype(h.dtype) * jax.nn.silu(gb.reshape(B, T, B_HEADS, B_DV))
    out = jnp.concatenate([oa.reshape(B, T, -1), ob.reshape(B, T, -1)], axis=-1) @ w_out
    return out, ctx_out


def cd_mixer(h, rope, ctx, w_in, w_out, lam_re, lam_im, log_dt, b_re, b_im, c_re, c_im, d_skip,
             glu_w, glu_b, q_g, k_g, lam_p, subln_g, lam_init):
    B, T, _ = h.shape
    u, qd, kd, vd = split_cols(h @ w_in, CD_SPLITS)
    qd = rms_norm(qd.reshape(B, T, D_HEADS, 2, D_QK), q_g)
    kd = rms_norm(kd.reshape(B, T, D_HEADS, 2, D_QK), k_g)
    vd = vd.reshape(B, T, D_HEADS, D_V)
    lp = lam_p.astype(jnp.float32)
    lam = jnp.exp(jnp.sum(lp[0] * lp[1])) - jnp.exp(jnp.sum(lp[2] * lp[3])) + lam_init
    if ctx is None:
        h0 = jnp.zeros((B, 2, C_GROUPS, C_STATE), jnp.float32)
        y, fin_re, fin_im = s5_bidir(u, lam_re, lam_im, log_dt, b_re, b_im, c_re, c_im, d_skip, h0, h0)
        od = over_query_blocks(lambda bi, qblk: diff_attend(qblk, kd, vd, lam), qd)
        ctx_out = (fin_re, fin_im, kd, vd)
    else:
        h0_re, h0_im, ck, cv = ctx
        y, _, _ = s5_bidir(u, lam_re, lam_im, log_dt, b_re, b_im, c_re, c_im, d_skip, h0_re, h0_im)
        k_all = jnp.concatenate([ck, apply_rope(kd, rope)], axis=1)
        v_all = jnp.concatenate([cv, vd], axis=1)
        od = over_query_blocks(lambda bi, qblk: diff_attend(qblk, k_all, v_all, lam), apply_rope(qd, rope))
        ctx_out = None
    g = jax.nn.gelu(y)
    oc = g * jax.nn.sigmoid(g @ glu_w + glu_b)
    od = rms_norm(od, subln_g) * (1.0 - lam_init)
    out = jnp.concatenate([oc, od.reshape(B, T, -1)], axis=-1) @ w_out
    return out, ctx_out


def trunk_layer(x, cond, mixer, ada_w, ada_b, n1_g, n2_g, w1, w3, w2):
    sh1, sc1, g1, sh2, sc2, g2 = ada_modulation(cond, ada_w, ada_b)
    h = rms_norm(x, n1_g) * (1.0 + sc1) + sh1
    out, ctx_out = mixer(h)
    x = x + g1 * out
    h = rms_norm(x, n2_g) * (1.0 + sc2) + sh2
    x = x + g2 * swiglu(h, w1, w3, w2)
    return x, ctx_out


def setup_inputs(seed: int = 0) -> dict:
    key = jax.random.key(seed)
    keys = iter(jax.random.split(key, 64))
    f32 = jnp.float32
    def nrm(shape, scale=1.0):
        return scale * jax.random.normal(next(keys), shape, f32)
    ret_e = 5.0 + jnp.arange(B_HEADS, dtype=f32)
    ret_logit = jnp.log1p(-(2.0 ** -ret_e)) + ret_e * math.log(2.0)
    n_idx = jnp.arange(C_STATE, dtype=f32)
    return {
        'x_prompt': nrm((BATCH, SEQ, D_MODEL)),
        'x_sample': nrm((DEC_BATCH, DEC_SEQ, D_MODEL)),
        'c': nrm((DEC_BATCH, D_MODEL)),
        'c_ctx': nrm((D_MODEL,)),
        'cache_k_a': nrm((DEC_BATCH, N_AB, PAST_LEN, A_KV_HEADS, HEAD_DIM)),
        'cache_v_a': nrm((DEC_BATCH, N_AB, PAST_LEN, A_KV_HEADS, HEAD_DIM)),
        'state_ret': nrm((DEC_BATCH, N_AB, 2, B_HEADS, B_DK, B_DV)),
        'state_ssm_re': nrm((DEC_BATCH, N_CD, 2, C_GROUPS, C_STATE), 0.1),
        'state_ssm_im': nrm((DEC_BATCH, N_CD, 2, C_GROUPS, C_STATE), 0.1),
        'cache_k_d': nrm((DEC_BATCH, N_CD, PAST_LEN, D_HEADS, 2, D_QK)),
        'cache_v_d': nrm((DEC_BATCH, N_CD, PAST_LEN, D_HEADS, D_V)),
        'ada_w': nrm((DEPTH, D_MODEL, 6 * D_MODEL), 0.5 * D_MODEL ** -0.5),
        'ada_b': nrm((DEPTH, 6 * D_MODEL), 0.02),
        'norm1_g': 1.0 + nrm((DEPTH, D_MODEL), 0.02),
        'norm2_g': 1.0 + nrm((DEPTH, D_MODEL), 0.02),
        'ffn_w1': nrm((DEPTH, D_MODEL, FFN_HIDDEN), D_MODEL ** -0.5),
        'ffn_w3': nrm((DEPTH, D_MODEL, FFN_HIDDEN), D_MODEL ** -0.5),
        'ffn_w2': nrm((DEPTH, FFN_HIDDEN, D_MODEL), FFN_HIDDEN ** -0.5),
        'ab_w_in': nrm((N_AB, D_MODEL, AB_COLS), D_MODEL ** -0.5),
        'ab_w_out': nrm((N_AB, AB_OUT, D_MODEL), AB_OUT ** -0.5),
        'a_q_norm': 1.0 + nrm((N_AB, HEAD_DIM), 0.02),
        'a_k_norm': 1.0 + nrm((N_AB, HEAD_DIM), 0.02),
        'a_sink': nrm((N_AB, A_HEADS), 0.5),
        'ret_decay': ret_logit + nrm((N_AB, 2, B_HEADS), 0.1),
        'ret_norm': 1.0 + nrm((N_AB, B_DV), 0.02),
        'cd_w_in': nrm((N_CD, D_MODEL, CD_COLS), D_MODEL ** -0.5),
        'cd_w_out': nrm((N_CD, CD_OUT, D_MODEL), CD_OUT ** -0.5),
        'ssm_lambda_re': -0.5 + nrm((N_CD, 2, C_GROUPS, C_STATE), 0.01),
        'ssm_lambda_im': math.pi * n_idx + nrm((N_CD, 2, C_GROUPS, C_STATE), 0.01),
        'ssm_log_dt': jax.random.uniform(next(keys), (N_CD, 2, C_GROUPS), f32, math.log(1e-3), math.log(1e-1)),
        'ssm_b_re': nrm((N_CD, C_GROUPS, C_STATE, C_GROUP), (2 * C_GROUP) ** -0.5),
        'ssm_b_im': nrm((N_CD, C_GROUPS, C_STATE, C_GROUP), (2 * C_GROUP) ** -0.5),
        'ssm_c_re': nrm((N_CD, C_GROUPS, C_GROUP, C_STATE), (2 * C_STATE) ** -0.5),
        'ssm_c_im': nrm((N_CD, C_GROUPS, C_GROUP, C_STATE), (2 * C_STATE) ** -0.5),
        'ssm_d': nrm((N_CD, C_WIDTH)),
        'ssm_glu_w': nrm((N_CD, C_WIDTH, C_WIDTH), C_WIDTH ** -0.5),
        'ssm_glu_b': nrm((N_CD, C_WIDTH), 0.02),
        'd_q_norm': 1.0 + nrm((N_CD, D_QK), 0.02),
        'd_k_norm': 1.0 + nrm((N_CD, D_QK), 0.02),
        'd_lambda': nrm((N_CD, 4, D_QK), 0.1),
        'd_subln': 1.0 + nrm((N_CD, D_V), 0.02),
    }


def reference(x_prompt, x_sample, c, c_ctx, cache_k_a, cache_v_a, state_ret, state_ssm_re, state_ssm_im,
              cache_k_d, cache_v_d, ada_w, ada_b, norm1_g, norm2_g, ffn_w1, ffn_w3, ffn_w2,
              ab_w_in, ab_w_out, a_q_norm, a_k_norm, a_sink, ret_decay, ret_norm,
              cd_w_in, cd_w_out, ssm_lambda_re, ssm_lambda_im, ssm_log_dt, ssm_b_re, ssm_b_im,
              ssm_c_re, ssm_c_im, ssm_d, ssm_glu_w, ssm_glu_b, d_q_norm, d_k_norm, d_lambda, d_subln):
    rope = axial_rope(x_sample.shape[1], HEAD_DIM)
    yp, ys = x_prompt, x_sample
    new_ka, new_va, new_ret, new_sr, new_si, new_kd, new_vd = [], [], [], [], [], [], []
    for l in range(DEPTH):
        j = l // 2
        ffn_p = (ada_w[l], ada_b[l], norm1_g[l], norm2_g[l], ffn_w1[l], ffn_w3[l], ffn_w2[l])
        if l % 2 == 0:
            mix_p = (ab_w_in[j], ab_w_out[j], a_q_norm[j], a_k_norm[j], a_sink[j], ret_decay[j], ret_norm[j])
            yp, (k_a, v_a, s_r) = trunk_layer(yp, c_ctx, lambda h: ab_mixer(h, None, None, *mix_p), *ffn_p)
            ctx_l = (cache_k_a[:, j], cache_v_a[:, j], state_ret[:, j])
            ys, _ = trunk_layer(ys, c, lambda h: ab_mixer(h, rope, ctx_l, *mix_p), *ffn_p)
            new_ka.append(k_a)
            new_va.append(v_a)
            new_ret.append(s_r)
        else:
            lam_init = 0.8 - 0.6 * math.exp(-0.3 * l)
            mix_p = (cd_w_in[j], cd_w_out[j], ssm_lambda_re[j], ssm_lambda_im[j], ssm_log_dt[j],
                     ssm_b_re[j], ssm_b_im[j], ssm_c_re[j], ssm_c_im[j], ssm_d[j], ssm_glu_w[j], ssm_glu_b[j],
                     d_q_norm[j], d_k_norm[j], d_lambda[j], d_subln[j], lam_init)
            yp, (s_re, s_im, k_d, v_d) = trunk_layer(yp, c_ctx, lambda h: cd_mixer(h, None, None, *mix_p), *ffn_p)
            ctx_l = (state_ssm_re[:, j], state_ssm_im[:, j], cache_k_d[:, j], cache_v_d[:, j])
            ys, _ = trunk_layer(ys, c, lambda h: cd_mixer(h, rope, ctx_l, *mix_p), *ffn_p)
            new_sr.append(s_re)
            new_si.append(s_im)
            new_kd.append(k_d)
            new_vd.append(v_d)
    new_cache_k_a = jnp.stack(new_ka, axis=1)
    new_cache_v_a = jnp.stack(new_va, axis=1)
    new_state_ret = jnp.stack(new_ret, axis=1)
    new_state_ssm_re = jnp.stack(new_sr, axis=1)
    new_state_ssm_im = jnp.stack(new_si, axis=1)
    new_cache_k_d = jnp.stack(new_kd, axis=1)
    new_cache_v_d = jnp.stack(new_vd, axis=1)
    return (yp, ys, new_cache_k_a, new_cache_v_a, new_state_ret, new_state_ssm_re, new_state_ssm_im,
            new_cache_k_d, new_cache_v_d)
```

```cpp
#include <hip/hip_runtime.h>
#include <hip/hip_cooperative_groups.h>
#include <cstdio>
namespace cg = cooperative_groups;

typedef __bf16 hf;
typedef __bf16 h8 __attribute__((ext_vector_type(8)));
typedef __bf16 h4 __attribute__((ext_vector_type(4)));
typedef __bf16 h2 __attribute__((ext_vector_type(2)));
typedef float f16v __attribute__((ext_vector_type(16)));
typedef float f4 __attribute__((ext_vector_type(4)));
#define MFMA16(a, b, c) __builtin_amdgcn_mfma_f32_16x16x32_bf16((a), (b), (c), 0, 0, 0)
struct Acc { f4 v[4][8]; };
typedef short s4v __attribute__((__vector_size__(4 * sizeof(short))));
typedef __attribute__((address_space(3))) s4v* lds_s4p;

#define DI __device__ __forceinline__
#define MFMA(a, b, c) __builtin_amdgcn_mfma_f32_32x32x16_bf16((a), (b), (c), 0, 0, 0)

constexpr int NP = 8192;
constexpr int NT = 40960;
constexpr int FH = 2816;
constexpr float LOG2E = 1.4426950408889634f;
constexpr float QSCALE = 0.125f * LOG2E;
constexpr float KSC = 256.f;
constexpr float NEGBIG = -1e30f;

constexpr size_t OFF_H16 = 0;
constexpr size_t OFF_R1 = 83886080;
constexpr size_t OFF_R2 = OFF_R1 + 230686720;
constexpr size_t OFF_W = OFF_R2 + 125829120;
constexpr size_t W_IN0 = OFF_W;
constexpr size_t W_OUT0 = W_IN0 + 5767168;
constexpr size_t W_130 = W_OUT0 + 2097152;
constexpr size_t W_20 = W_130 + 11534336;
constexpr size_t W_IN1 = W_20 + 5767168;
constexpr size_t W_OUT1 = W_IN1 + 4194304;
constexpr size_t W_131 = W_OUT1 + 2097152;
constexpr size_t W_21 = W_131 + 11534336;
constexpr size_t W_GLU = W_21 + 5767168;
constexpr size_t OFF_MISC = W_GLU + 524288;
constexpr size_t M_MOD = OFF_MISC;
constexpr size_t M_CKA = M_MOD + 442368;
constexpr size_t M_CVA = M_CKA + 524288;
constexpr size_t M_CKD = M_CVA + 524288;
constexpr size_t M_CVD = M_CKD + 2097152;
constexpr size_t M_ROPE = M_CVD + 2097152;
constexpr size_t M_SCAL = M_ROPE + 8192;
constexpr size_t M_BAR = M_SCAL + 256;
constexpr size_t WS_END = M_BAR + 16384;
constexpr size_t R1_QA = OFF_R1, R1_KA = R1_QA + 41943040, R1_VA = R1_KA + 10485760, R1_QB = R1_VA + 10485760,
                 R1_KB = R1_QB + 41943040, R1_VB = R1_KB + 41943040, R1_GB = R1_VB + 41943040;
constexpr size_t R1_UG = OFF_R1, R1_QD = R1_UG + 41943040, R1_KD = R1_QD + 41943040, R1_VD = R1_KD + 41943040, R1_G16 = R1_VD + 41943040;
constexpr size_t R1_T16 = OFF_R1;
constexpr size_t R2_KVC = OFF_R2, R2_STT = R2_KVC + 83886080;
constexpr size_t R2_KC = OFF_R2, R2_FC = R2_KC + 2097152, R2_E = R2_FC + 16777216, R2_SC = R2_E + 16777216, R2_H = R2_SC + 20971520;
constexpr size_t O_Y = 0, O_KA = 41943040, O_VA = O_KA + 1048576, O_RET = O_VA + 1048576, O_SRE = O_RET + 2097152,
                 O_SIM = O_SRE + 131072, O_KD = O_SIM + 131072, O_VD = O_KD + 4194304;

constexpr int HALF_LDS = 67584;
constexpr int LDS_BYTES = 2 * HALF_LDS;
constexpr int NTHR = 512;

struct P { const float* in[41]; float* out; unsigned char* ws; };
typedef const __attribute__((address_space(4))) P* PP;

DI int opaque_tid() { int t = threadIdx.x; asm volatile("" : "+v"(t)); return t; }
DI int opaque_s(int x) { asm volatile("" : "+s"(x)); return x; }
DI PP opaque_p(PP p) { unsigned long long u = (unsigned long long)p; asm volatile("" : "+s"(u)); return (PP)u; }
DI int crow(int i, int hh) { return (i & 3) + 8 * (i >> 2) + 4 * hh; }
DI h4 trread(const hf* p) { s4v r = __builtin_amdgcn_ds_read_tr16_b64_v4i16((lds_s4p)(p)); return __builtin_bit_cast(h4, r); }
DI h8 cat8(h4 a, h4 b) { return __builtin_shufflevector(a, b, 0, 1, 2, 3, 4, 5, 6, 7); }
DI float ex2(float x) { return __builtin_amdgcn_exp2f(x); }
DI float sigmoidf_(float x) { return __builtin_amdgcn_rcpf(1.f + ex2(-LOG2E * x)); }
DI float siluf_(float x) { return x * __builtin_amdgcn_rcpf(1.f + ex2(-LOG2E * x)); }
DI float gelu_tanh(float x) { float u = 0.7978845608028654f * (x + 0.044715f * x * x * x); float e = ex2(-2.f * LOG2E * fabsf(u)); float t = (1.f - e) * __builtin_amdgcn_rcpf(1.f + e); t = u < 0.f ? -t : t; return 0.5f * x * (1.f + t); }
DI h2 pk(float a, float b) { h2 r; r[0] = (hf)a; r[1] = (hf)b; return r; }
DI h8 pack8(const f16v& x, int s) {
  h2 a = pk(x[8 * s + 0], x[8 * s + 1]), b = pk(x[8 * s + 2], x[8 * s + 3]), c = pk(x[8 * s + 4], x[8 * s + 5]), d = pk(x[8 * s + 6], x[8 * s + 7]);
  h8 r; r[0] = a[0]; r[1] = a[1]; r[2] = b[0]; r[3] = b[1]; r[4] = c[0]; r[5] = c[1]; r[6] = d[0]; r[7] = d[1]; return r;
}
DI f16v zero16() { f16v z; for (int i = 0; i < 16; ++i) z[i] = 0.f; return z; }
DI void cpowd(double lr, double li, double dt, int n, double& re, double& im) {
  const double mag = exp(lr * dt * (double)n);
  const double rev = li * dt * (double)n * 0.15915494309189535;
  const double th = (rev - floor(rev)) * 6.283185307179586;
  re = mag * cos(th); im = mag * sin(th);
}

DI size_t tix(int row, int k, int nrows) { return ((size_t)(k >> 5) * (size_t)nrows + (size_t)row) * 32 + (size_t)(k & 31); }
struct LdTiled { const hf* base; int nrows; int row0; DI const hf* operator()(int r, int k) const { return base + tix(row0 + r, k, nrows); } };
struct LdToep { const hf* kc; int row0; DI const hf* operator()(int r, int k) const { int n = row0 + r; int t = n >> 4, co = n & 15, s = k >> 4, ci = k & 15; return kc + ((t - s + 63) * 16 + co) * 16 + ci; } };

#define RAW_BARRIER() do { asm volatile("s_waitcnt lgkmcnt(0)" ::: "memory"); __builtin_amdgcn_s_barrier(); } while (0)
typedef __attribute__((address_space(3))) unsigned* lds_u32p;
typedef __attribute__((address_space(1))) const unsigned* glb_u32p;

constexpr int STG = (256 + 256) * 32;
DI int swz4(int x) { return (0x78 >> (2 * x)) & 3; }
template <class LA, class LB>
DI void gemm_piece(const LA& la, const LB& lb, int kt, int buf, int piece, hf* sm, int tid) {
  const int w = tid >> 6, l = tid & 63;
  const int rl = l >> 2, cch = ((l & 3) ^ swz4((l >> 4) & 3)) * 8;
  hf* st = sm + buf * STG;
  const int k = kt * 32 + cch;
  const int blk = w * 2 + (piece & 1);
  if (piece < 2) __builtin_amdgcn_global_load_lds((glb_u32p)la(blk * 16 + rl, k), (lds_u32p)(st + blk * 512), 16, 0, 0);
  else __builtin_amdgcn_global_load_lds((glb_u32p)lb(blk * 16 + rl, k), (lds_u32p)(st + 256 * 32 + blk * 512), 16, 0, 0);
}
template <class LA, class LB>
DI void gemm_issue(const LA& la, const LB& lb, int kt, int buf, hf* sm, int tid) {
#pragma unroll
  for (int pc = 0; pc < 4; ++pc) gemm_piece(la, lb, kt, buf, pc, sm, tid);
}
template <class LA, class LB>
DI void gemm_prologue(const LA& la, const LB& lb, int nk, hf* sm, int tid) {
  gemm_issue(la, lb, 0, 0, sm, tid);
  if (nk > 1) gemm_issue(la, lb, 1, 1, sm, tid);
}
template <bool PF, class LA, class LB>
DI void gemm_stage(Acc& acc, const LA& la, const LB& lb, int kt, int buf, hf* sm, int tid) {
  const int w = tid >> 6, l = tid & 63, wm = w >> 1, wn = w & 1, r16 = l & 15, c4 = l >> 4;
  const int slot = (c4 ^ swz4((r16 >> 2) & 3)) * 8;
  const int nb = buf >= 1 ? buf - 1 : 2;
  const hf* sa = sm + buf * STG + (wm * 64 + r16) * 32 + slot;
  const hf* sb = sm + buf * STG + 256 * 32 + (wn * 128 + r16) * 32 + slot;
  h8 af[4], bf[8];
#pragma unroll
  for (int m = 0; m < 4; ++m) af[m] = *(const h8*)(sa + m * 16 * 32);
#pragma unroll
  for (int n = 0; n < 8; ++n) bf[n] = *(const h8*)(sb + n * 16 * 32);
#pragma unroll
  for (int g = 0; g < 2; ++g)
#pragma unroll
    for (int m = 0; m < 4; ++m) { acc.v[m][2 * g] = MFMA16(af[m], bf[2 * g], acc.v[m][2 * g]); acc.v[m][2 * g + 1] = MFMA16(af[m], bf[2 * g + 1], acc.v[m][2 * g + 1]); }
  __builtin_amdgcn_sched_barrier(0);
#pragma unroll
  for (int g = 2; g < 4; ++g) {
#pragma unroll
    for (int m = 0; m < 4; ++m) { acc.v[m][2 * g] = MFMA16(af[m], bf[2 * g], acc.v[m][2 * g]); acc.v[m][2 * g + 1] = MFMA16(af[m], bf[2 * g + 1], acc.v[m][2 * g + 1]); }
    if (PF) { gemm_piece(la, lb, kt + 2, nb, 2 * (g - 2), sm, tid); gemm_piece(la, lb, kt + 2, nb, 2 * (g - 2) + 1, sm, tid); }
  }
  __builtin_amdgcn_sched_barrier(0);
}
template <class LA, class LB>
DI void gemm_loop(Acc& acc, const LA& la, const LB& lb, int nk, hf* sm, int tid) {
  int buf = 0;
  for (int kt = 0; kt < nk - 2; ++kt) {
    if (kt > 0) asm volatile("s_waitcnt vmcnt(4)" ::: "memory"); else asm volatile("s_waitcnt vmcnt(0)" ::: "memory");
    RAW_BARRIER();
    gemm_stage<true>(acc, la, lb, kt, buf, sm, tid);
    buf = buf == 2 ? 0 : buf + 1;
  }
  for (int kt = (nk >= 2 ? nk - 2 : 0); kt < nk; ++kt) {
    if (kt > 0 && kt + 1 < nk) asm volatile("s_waitcnt vmcnt(4)" ::: "memory"); else asm volatile("s_waitcnt vmcnt(0)" ::: "memory");
    RAW_BARRIER();
    gemm_stage<false>(acc, la, lb, kt, buf, sm, tid);
    buf = buf == 2 ? 0 : buf + 1;
  }
  RAW_BARRIER();
}
template <class LA, class LB>
DI void gemm_main(Acc& acc, const LA& la, const LB& lb, int nk, hf* sm, int tid) {
  gemm_prologue(la, lb, nk, sm, tid);
  gemm_loop(acc, la, lb, nk, sm, tid);
  __syncthreads();
}
DI void zero_acc(Acc& acc) {
#pragma unroll
  for (int m = 0; m < 4; ++m)
#pragma unroll
    for (int n = 0; n < 8; ++n) { acc.v[m][n][0] = 0.f; acc.v[m][n][1] = 0.f; acc.v[m][n][2] = 0.f; acc.v[m][n][3] = 0.f; }
}
DI void acc_to_lds(const Acc& acc, float* ct0, int tid, int pass) {
  const int w = tid >> 6, l = tid & 63, wm = w >> 1, wn = w & 1, r16 = l & 15, c4 = l >> 4;
  if (wn == pass) {
    float* ct = ct0 + (wm >> 1) * (HALF_LDS / 4);
#pragma unroll
    for (int m = 0; m < 4; ++m)
#pragma unroll
      for (int n = 0; n < 8; ++n)
#pragma unroll
        for (int i = 0; i < 4; ++i) ct[((wm & 1) * 64 + m * 16 + 4 * c4 + i) * 132 + n * 16 + r16] = acc.v[m][n][i];
  }
}
DI void tile_map(int t, int G, int total, int ntn, int& mt, int& nt) {
  const int q = t / G, b = t - q * G;
  const int rem = total - q * G;
  const int per = (rem >= G ? G : rem) >> 3;
  const int L = q * G + (b & 7) * per + (b >> 3);
  const int grp = 8 * ntn;
  const int mb = L / grp, r = L - mb * grp;
  nt = r >> 3; mt = mb * 8 + (r & 7);
}
DI void ld16(const float* ct, int r, int c16, float (&v)[16]) {
#pragma unroll
  for (int j = 0; j < 4; ++j) { f4 t = *(const f4*)(ct + r * 132 + c16 * 16 + 4 * j); v[4 * j] = t[0]; v[4 * j + 1] = t[1]; v[4 * j + 2] = t[2]; v[4 * j + 3] = t[3]; }
}
DI void st16h(hf* dst, const float (&v)[16]) {
  h8 a, b;
#pragma unroll
  for (int j = 0; j < 8; ++j) { a[j] = (hf)v[j]; b[j] = (hf)v[8 + j]; }
  *(h8*)dst = a; *(h8*)(dst + 8) = b;
}
DI void st16f(float* dst, const float (&v)[16]) {
#pragma unroll
  for (int j = 0; j < 4; ++j) { f4 t; t[0] = v[4 * j]; t[1] = v[4 * j + 1]; t[2] = v[4 * j + 2]; t[3] = v[4 * j + 3]; *(f4*)(dst + 4 * j) = t; }
}
DI float quad_xor1(float x) { return __builtin_bit_cast(float, __builtin_amdgcn_mov_dpp(__builtin_bit_cast(int, x), 0xB1, 0xF, 0xF, true)); }
DI float quad_xor2(float x) { return __builtin_bit_cast(float, __builtin_amdgcn_mov_dpp(__builtin_bit_cast(int, x), 0x4E, 0xF, 0xF, true)); }
DI void rope16(float (&v)[16], int q, int tpos, const float* rope) {
  const int pos = (q & 1) ? (tpos & 63) : (tpos >> 6);
  const float* rp = rope + pos * 32;
#pragma unroll
  for (int j = 0; j < 16; ++j) {
    float pv = quad_xor2(v[j]);
    float c = rp[2 * j], s = rp[2 * j + 1];
    v[j] = (q < 2) ? (v[j] * c - pv * s) : (v[j] * c + pv * s);
  }
}
DI void norm16(float (&v)[16], const float* gam, int q) {
  float ss = 0.f;
#pragma unroll
  for (int j = 0; j < 16; ++j) ss += v[j] * v[j];
  ss += quad_xor1(ss); ss += quad_xor2(ss);
  const float rstd = rsqrtf(ss * (1.f / 64.f) + 1e-6f);
#pragma unroll
  for (int j = 0; j < 16; ++j) v[j] = v[j] * rstd * gam[q * 16 + j];
}

struct KVSeg { const hf* K; const hf* V; int kld, vld, ntiles, kpos0; };

template <int DV>
DI void attn_run(f16v (&O)[DV / 32], const hf* Q, int qld, const KVSeg& s0, const KVSeg& s1, float m_init, float l_init, int qpos0, bool band, hf* sm, int tid) {
  constexpr int VS = DV + 32;
  constexpr int NV = DV / 32;
  hf* sK = sm; hf* sV = sm + 2 * 64 * 72;
  const int w = tid >> 6, l = tid & 63, lr32 = l & 31, hh = l >> 5;
  h8 qf[4];
  {
    const hf* qp = Q + (size_t)(w * 32 + lr32) * qld + 8 * hh;
#pragma unroll
    for (int ks = 0; ks < 4; ++ks) qf[ks] = *(const h8*)(qp + ks * 16);
  }
  float m = m_init, ls = hh == 0 ? l_init : 0.f;
#pragma unroll
  for (int d = 0; d < NV; ++d) O[d] = zero16();
  const int n0 = s0.ntiles, ntot = s0.ntiles + s1.ntiles;
  const int kr = tid >> 3, kc = (tid & 7) * 8;
  const int vr = (DV == 64) ? (tid >> 3) : (tid >> 4), vc = (DV == 64) ? (tid & 7) * 8 : (tid & 15) * 8;
  constexpr int VRS = (DV == 64) ? 32 : 16;
  h8 rk[2], rv[NV];
  auto gload = [&](int i) {
    const hf* kp; const hf* vp; int kld, vld;
    if (i < n0) { kp = s0.K + (size_t)(i * 64) * s0.kld; vp = s0.V + (size_t)(i * 64) * s0.vld; kld = s0.kld; vld = s0.vld; }
    else { kp = s1.K + (size_t)((i - n0) * 64) * s1.kld; vp = s1.V + (size_t)((i - n0) * 64) * s1.vld; kld = s1.kld; vld = s1.vld; }
#pragma unroll
    for (int j = 0; j < 2; ++j) rk[j] = *(const h8*)(kp + (size_t)(kr + 32 * j) * kld + kc);
#pragma unroll
    for (int j = 0; j < NV; ++j) rv[j] = *(const h8*)(vp + (size_t)(vr + VRS * j) * vld + vc);
  };
  auto sstore = [&](int buf) {
#pragma unroll
    for (int j = 0; j < 2; ++j) *(h8*)(sK + buf * 64 * 72 + (kr + 32 * j) * 72 + kc) = rk[j];
#pragma unroll
    for (int j = 0; j < NV; ++j) *(h8*)(sV + buf * 64 * VS + (vr + VRS * j) * VS + vc) = rv[j];
  };
  gload(0); sstore(0);
  __syncthreads();
  const int i16 = l & 15, q4 = i16 >> 2, p4 = i16 & 3, blk = (l >> 4) & 1;
  const int voff = (4 * hh + q4) * VS + 16 * blk + 4 * p4;
  const int qmin = qpos0 + w * 32, qpos = qmin + lr32;
  for (int i = 0; i < ntot; ++i) {
    const int cur = i & 1;
    if (i + 1 < ntot) gload(i + 1);
    const bool masked = band && i >= n0;
    const int kbase = s1.kpos0 + (i - n0) * 64;
    const bool skip = masked && (kbase > qmin + 31 + 128 || kbase + 63 < qmin - 128);
    if (!skip) {
      f16v st[2];
#pragma unroll
      for (int kb = 0; kb < 2; ++kb) {
        st[kb] = zero16();
        const hf* kp = sK + cur * 64 * 72 + (kb * 32 + lr32) * 72 + 8 * hh;
#pragma unroll
        for (int ks = 0; ks < 4; ++ks) { h8 kf = *(const h8*)(kp + ks * 16); st[kb] = MFMA(kf, qf[ks], st[kb]); }
      }
      if (masked) {
#pragma unroll
        for (int kb = 0; kb < 2; ++kb)
#pragma unroll
          for (int e = 0; e < 16; ++e) { int kpos = kbase + kb * 32 + crow(e, hh); int dd = qpos - kpos; if (dd > 128 || dd < -128) st[kb][e] = NEGBIG; }
      }
      float mx = st[0][0];
#pragma unroll
      for (int kb = 0; kb < 2; ++kb)
#pragma unroll
        for (int e = 0; e < 16; ++e) mx = fmaxf(mx, st[kb][e]);
      mx = fmaxf(mx, __shfl_xor(mx, 32));
      const float mnew = fmaxf(m, mx);
      const float alpha = ex2(m - mnew);
      m = mnew;
      float psum = 0.f;
#pragma unroll
      for (int kb = 0; kb < 2; ++kb)
#pragma unroll
        for (int e = 0; e < 16; ++e) { float pe = ex2(st[kb][e] - mnew); st[kb][e] = pe; psum += pe; }
      ls = ls * alpha + psum;
      if (__builtin_amdgcn_ballot_w64(alpha != 1.f) != 0ull) {
#pragma unroll
        for (int d = 0; d < NV; ++d)
#pragma unroll
          for (int e = 0; e < 16; ++e) O[d][e] *= alpha;
      }
      const hf* vb = sV + cur * 64 * VS + voff;
#pragma unroll
      for (int kb = 0; kb < 2; ++kb)
#pragma unroll
        for (int s = 0; s < 2; ++s) {
          const h8 pf = pack8(st[kb], s);
          const hf* vp = vb + (kb * 32 + 16 * s) * VS;
#pragma unroll
          for (int d = 0; d < NV; ++d) {
            h8 vf = cat8(trread(vp + d * 32), trread(vp + 8 * VS + d * 32));
            O[d] = MFMA(vf, pf, O[d]);
          }
        }
    }
    if (i + 1 < ntot) sstore(cur ^ 1);
    __syncthreads();
  }
  const float lt = ls + __shfl_xor(ls, 32);
  const float inv = 1.f / lt;
#pragma unroll
  for (int d = 0; d < NV; ++d)
#pragma unroll
    for (int e = 0; e < 16; ++e) O[d][e] *= inv;
}

DI void transpose_tile(const float* src, int N, hf* dst, int nrows, int kt, int nt, int drow0, float* tile, int tid) {
#pragma unroll
  for (int i = 0; i < 4; ++i) {
    int k = (tid >> 4) + 16 * i, n4 = (tid & 15) * 4;
    f4 v = *(const f4*)(src + (size_t)(kt * 64 + k) * N + nt * 64 + n4);
    tile[k * 65 + n4] = v[0]; tile[k * 65 + n4 + 1] = v[1]; tile[k * 65 + n4 + 2] = v[2]; tile[k * 65 + n4 + 3] = v[3];
  }
  __syncthreads();
  {
    int n = tid >> 2, kc = (tid & 3) * 16;
    h8 a, b;
#pragma unroll
    for (int j = 0; j < 8; ++j) { a[j] = (hf)tile[(kc + j) * 65 + n]; b[j] = (hf)tile[(kc + 8 + j) * 65 + n]; }
    hf* d = dst + tix(drow0 + n, kt * 64 + kc, nrows);
    *(h8*)d = a; *(h8*)(d + 8) = b;
  }
  __syncthreads();
}

template <int PART>
DI void phase_prep(PP p, unsigned char* smem) {
  const int tf = opaque_tid(); const int half = tf >> 8; const int tid = tf & 255;
  float* smf = (float*)(smem + half * HALF_LDS);
  constexpr int NTR = 6016, NADA = 192, NCV = 1280;
  const int G = gridDim.x, bid = opaque_s(blockIdx.x);
  const int count = PART == 0 ? 1536 + 737 : PART == 1 ? 1120 : 352;
  const int start = PART == 0 ? bid : bid - (G >> 1), stride = PART == 0 ? G : G - (G >> 1);
  if (PART != 0 && bid < (G >> 1)) return;
  for (int idx = start; idx < count; idx += stride) {
    const int pit = PART == 0 ? (idx < 1536 ? idx : 3008 + (idx - 1536)) : PART == 1 ? (idx < 1088 ? 1536 + idx : 2976 + (idx - 1088)) : 2624 + idx;
    const int it = pit < (NTR + NADA + NCV) / 2 ? 2 * pit + half : NTR + NADA + NCV + half;
    if (it < NTR) {
      int t = it; const float* src; hf* dst; int K, N, ldk, inter = 0;
      if (t < 704) { src = p->in[18]; dst = (hf*)(p->ws + W_IN0); K = 1024; N = 2816; }
      else if ((t -= 704) < 256) { src = p->in[19]; dst = (hf*)(p->ws + W_OUT0); K = 1024; N = 1024; }
      else if ((t -= 256) < 704) { src = p->in[15]; dst = (hf*)(p->ws + W_130); K = 1024; N = 2816; inter = 1; }
      else if ((t -= 704) < 704) { src = p->in[16]; dst = (hf*)(p->ws + W_130); K = 1024; N = 2816; inter = 2; }
      else if ((t -= 704) < 704) { src = p->in[17]; dst = (hf*)(p->ws + W_20); K = 2816; N = 1024; }
      else if ((t -= 704) < 512) { src = p->in[25]; dst = (hf*)(p->ws + W_IN1); K = 1024; N = 2048; }
      else if ((t -= 512) < 256) { src = p->in[26]; dst = (hf*)(p->ws + W_OUT1); K = 1024; N = 1024; }
      else if ((t -= 256) < 704) { src = p->in[15] + (size_t)1024 * 2816; dst = (hf*)(p->ws + W_131); K = 1024; N = 2816; inter = 1; }
      else if ((t -= 704) < 704) { src = p->in[16] + (size_t)1024 * 2816; dst = (hf*)(p->ws + W_131); K = 1024; N = 2816; inter = 2; }
      else if ((t -= 704) < 704) { src = p->in[17] + (size_t)2816 * 1024; dst = (hf*)(p->ws + W_21); K = 2816; N = 1024; }
      else { t -= 704; src = p->in[35]; dst = (hf*)(p->ws + W_GLU); K = 512; N = 512; }
      ldk = inter ? 2 * N : N; (void)K;
      const int ntn = N / 64; const int kt = t / ntn, nt = t % ntn;
      const int drow0 = inter == 0 ? nt * 64 : (nt * 128 + (inter == 2 ? 64 : 0));
      transpose_tile(src, N, dst, ldk, kt, nt, drow0, smf, tid);
    } else if (it < NTR + NADA) {
      const int t = it - NTR; const int layer = t / 96, n0 = (t % 96) * 64;
      float* sc = smf;
      float* red = smf + 9 * 1024;
      for (int e = tid; e < 9 * 1024; e += 256) { int ci = e >> 10, k = e & 1023; float c = ci < 8 ? p->in[2][ci * 1024 + k] : p->in[3][k]; sc[e] = siluf_(c); }
      __syncthreads();
      const int col = tid & 63, kg = tid >> 6;
      const float* wp = p->in[11] + (size_t)layer * 1024 * 6144 + n0 + col;
      float a[9];
#pragma unroll
      for (int c = 0; c < 9; ++c) a[c] = 0.f;
#pragma unroll 4
      for (int k = kg * 256; k < kg * 256 + 256; ++k) {
        float wv = wp[(size_t)k * 6144];
#pragma unroll
        for (int c = 0; c < 9; ++c) a[c] += sc[c * 1024 + k] * wv;
      }
#pragma unroll
      for (int c = 0; c < 9; ++c) red[(kg * 9 + c) * 64 + col] = a[c];
      __syncthreads();
      float* mod = (float*)(p->ws + M_MOD);
      for (int e = tid; e < 9 * 64; e += 256) {
        int c = e >> 6, cl = e & 63;
        float s = red[(0 * 9 + c) * 64 + cl] + red[(1 * 9 + c) * 64 + cl] + red[(2 * 9 + c) * 64 + cl] + red[(3 * 9 + c) * 64 + cl];
        mod[((size_t)layer * 9 + c) * 6144 + n0 + cl] = s + p->in[12][layer * 6144 + n0 + cl];
      }
      __syncthreads();
    } else if (it < NTR + NADA + NCV) {
      int t = it - NTR - NADA;
      if (t < 128) {
        int e = (t * 256 + tid) * 8; int d = e & 63, key = (e >> 6) & 255, g = (e >> 14) & 1, b = e >> 15;
        const float* s = p->in[4] + ((size_t)(b * 256 + key) * 2 + g) * 64 + d;
        h8 o;
#pragma unroll
        for (int j = 0; j < 8; ++j) o[j] = (hf)s[j];
        *(h8*)((hf*)(p->ws + M_CKA) + e) = o;
      } else if ((t -= 128) < 128) {
        int e = (t * 256 + tid) * 8; int d = e & 63, key = (e >> 6) & 255, g = (e >> 14) & 1, b = e >> 15;
        const float* s = p->in[5] + ((size_t)(b * 256 + key) * 2 + g) * 64 + d;
        h8 o;
#pragma unroll
        for (int j = 0; j < 8; ++j) o[j] = (hf)s[j];
        *(h8*)((hf*)(p->ws + M_CVA) + e) = o;
      } else if ((t -= 128) < 512) {
        int e = (t * 256 + tid) * 8; int d = e & 63, key = (e >> 6) & 255, c = (e >> 14) & 1, h = (e >> 15) & 3, b = e >> 17;
        const float* s = p->in[9] + (((size_t)(b * 256 + key) * 4 + h) * 2 + c) * 64 + d;
        h8 o;
#pragma unroll
        for (int j = 0; j < 8; ++j) o[j] = (hf)s[j];
        *(h8*)((hf*)(p->ws + M_CKD) + e) = o;
      } else {
        t -= 512;
        int e = (t * 256 + tid) * 8; int d = e & 127, key = (e >> 7) & 255, h = (e >> 15) & 3, b = e >> 17;
        const float* s = p->in[10] + ((size_t)(b * 256 + key) * 4 + h) * 128 + d;
        h8 o;
#pragma unroll
        for (int j = 0; j < 8; ++j) o[j] = (hf)s[j];
        *(h8*)((hf*)(p->ws + M_CVD) + e) = o;
      }
    } else if (it == NTR + NADA + NCV) {
      float* rope = (float*)(p->ws + M_ROPE);
      for (int e = tid; e < 1024; e += 256) {
        int pos = e >> 4, f = e & 15;
        float inv = (float)exp2(-(double)f * (13.287712379549449 / 16.0));
        const double ang = (double)((float)pos * inv);
        rope[2 * e] = (float)cos(ang); rope[2 * e + 1] = (float)sin(ang);
      }
      float* scal = (float*)(p->ws + M_SCAL);
      if (tid == 0) {
        const float* lp = p->in[39];
        float s01 = 0.f, s23 = 0.f;
        for (int j = 0; j < 64; ++j) { s01 += lp[j] * lp[64 + j]; s23 += lp[128 + j] * lp[192 + j]; }
        scal[0] = __expf(s01) - __expf(s23) + 0.35550906759096994f;
      }
      if (tid >= 16 && tid < 32) { float x = p->in[23][tid - 16]; float e = __expf(-x); scal[tid] = -(e - 0.5f * e * e + 0.33333333f * e * e * e); }
    }
  }
}

DI void phase_norm(PP p, int layer, int which) {
  const float* gam = p->in[which ? 14 : 13] + layer * 1024;
  const float* mod = (const float*)(p->ws + M_MOD) + (size_t)layer * 9 * 6144;
  hf* h16 = (hf*)(p->ws + OFF_H16);
  const int tid = opaque_tid(); const int wave = tid >> 6, lane = tid & 63;
  const bool from_in = (layer == 0 && which == 0);
  const int G = gridDim.x;
  const int rpw = (((NT + G - 1) / G + 15) / 16) * 2;
  const int r0 = (opaque_s(blockIdx.x) * 8 + wave) * rpw;
  int cur = -1;
  float gm[16], shv[16];
#pragma unroll 1
  for (int row = r0; row < r0 + rpw && row < NT; row += 2) {
    const int cond = row < NP ? 8 : (row - NP) >> 12;
    if (cond != cur) {
      cur = cond;
      const float* sh = mod + cond * 6144 + (which ? 3 * 1024 : 0);
#pragma unroll
      for (int i = 0; i < 4; ++i) {
        const int k = lane * 4 + 256 * i;
        f4 g = *(const f4*)(gam + k), s1 = *(const f4*)(sh + 1024 + k), s0 = *(const f4*)(sh + k);
#pragma unroll
        for (int j = 0; j < 4; ++j) { gm[4 * i + j] = g[j] * (1.f + s1[j]); shv[4 * i + j] = s0[j]; }
      }
    }
    const float* x = from_in ? (row < NP ? p->in[0] + (size_t)row * 1024 : p->in[1] + (size_t)(row - NP) * 1024) : p->out + O_Y + (size_t)row * 1024;
    f4 va[4], vb[4]; float sa = 0.f, sb = 0.f;
#pragma unroll
    for (int i = 0; i < 4; ++i) { va[i] = *(const f4*)(x + lane * 4 + 256 * i); vb[i] = *(const f4*)(x + 1024 + lane * 4 + 256 * i); }
#pragma unroll
    for (int i = 0; i < 4; ++i) {
      sa += va[i][0] * va[i][0] + va[i][1] * va[i][1] + va[i][2] * va[i][2] + va[i][3] * va[i][3];
      sb += vb[i][0] * vb[i][0] + vb[i][1] * vb[i][1] + vb[i][2] * vb[i][2] + vb[i][3] * vb[i][3];
    }
#pragma unroll
    for (int o = 32; o >= 1; o >>= 1) { sa += __shfl_xor(sa, o); sb += __shfl_xor(sb, o); }
    const float ra = rsqrtf(sa * (1.f / 1024.f) + 1e-6f), rb = rsqrtf(sb * (1.f / 1024.f) + 1e-6f);
#pragma unroll
    for (int i = 0; i < 4; ++i) {
      const int k = lane * 4 + 256 * i;
      h4 oa, ob;
#pragma unroll
      for (int j = 0; j < 4; ++j) { oa[j] = (hf)(va[i][j] * ra * gm[4 * i + j] + shv[4 * i + j]); ob[j] = (hf)(vb[i][j] * rb * gm[4 * i + j] + shv[4 * i + j]); }
      *(h4*)(h16 + tix(row, k, NT)) = oa;
      *(h4*)(h16 + tix(row + 1, k, NT)) = ob;
    }
  }
}

DI void epi_ab(PP p, const float* ct, int row0, int nt, int tid) {
  const int c8 = tid & 7, q = c8 & 3;
  const float* rope = (const float*)(p->ws + M_ROPE);
  const bool latent = row0 >= NP;
#pragma unroll 1
  for (int ps = 0; ps < 4; ++ps) {
    const int r = ps * 32 + (tid >> 3); const int row = row0 + r;
    float v[16]; ld16(ct, r, c8, v);
    const int tpos = (row - NP) & 4095;
    if (nt < 4) {
      norm16(v, p->in[20], q);
      if (latent) rope16(v, q, tpos, rope);
#pragma unroll
      for (int j = 0; j < 16; ++j) v[j] *= QSCALE;
      st16h((hf*)(p->ws + R1_QA) + (size_t)row * 512 + nt * 128 + c8 * 16, v);
    } else if (nt == 4) {
      norm16(v, p->in[21], q);
      if (!latent) st16f(p->out + O_KA + (size_t)row * 128 + c8 * 16, v);
      else rope16(v, q, tpos, rope);
      st16h((hf*)(p->ws + R1_KA) + (size_t)row * 128 + c8 * 16, v);
    } else if (nt == 5) {
      if (!latent) st16f(p->out + O_VA + (size_t)row * 128 + c8 * 16, v);
      st16h((hf*)(p->ws + R1_VA) + (size_t)row * 128 + c8 * 16, v);
    } else {
      const int sel = (nt - 6) >> 2, sub = (nt - 6) & 3;
      if (sel == 0) {
#pragma unroll
        for (int j = 0; j < 16; ++j) v[j] *= 0.125f;
      }
      const size_t base = sel == 0 ? R1_QB : sel == 1 ? R1_KB : sel == 2 ? R1_VB : R1_GB;
      st16h((hf*)(p->ws + base) + (size_t)row * 512 + sub * 128 + c8 * 16, v);
    }
  }
}
DI void epi_cd(PP p, const float* ct, int row0, int nt, int tid) {
  const int c8 = tid & 7, q = c8 & 3;
  const float* rope = (const float*)(p->ws + M_ROPE);
  const bool latent = row0 >= NP;
#pragma unroll 1
  for (int ps = 0; ps < 4; ++ps) {
    const int r = ps * 32 + (tid >> 3); const int row = row0 + r;
    float v[16]; ld16(ct, r, c8, v);
    const int tpos = (row - NP) & 4095;
    if (nt < 4) {
      st16h((hf*)(p->ws + R1_UG) + (size_t)(nt * 8 + c8) * (NT * 16) + tix(row >> 6, (row & 63) * 16, 640), v);
    } else if (nt < 8) {
      norm16(v, p->in[37], q);
      if (latent) rope16(v, q, tpos, rope);
#pragma unroll
      for (int j = 0; j < 16; ++j) v[j] *= QSCALE;
      st16h((hf*)(p->ws + R1_QD) + (size_t)row * 512 + (nt - 4) * 128 + c8 * 16, v);
    } else if (nt < 12) {
      norm16(v, p->in[38], q);
      if (!latent) st16f(p->out + O_KD + (size_t)row * 512 + (nt - 8) * 128 + c8 * 16, v);
      else rope16(v, q, tpos, rope);
      st16h((hf*)(p->ws + R1_KD) + (size_t)row * 512 + (nt - 8) * 128 + c8 * 16, v);
    } else {
      if (!latent) st16f(p->out + O_VD + (size_t)row * 512 + (nt - 12) * 128 + c8 * 16, v);
      st16h((hf*)(p->ws + R1_VD) + (size_t)row * 512 + (nt - 12) * 128 + c8 * 16, v);
    }
  }
}
DI void epi_res(PP p, const float* ct, int row0, int nt, int tid, int layer, int gi, bool from_in) {
  const int c8 = tid & 7;
  const float* mod = (const float*)(p->ws + M_MOD) + (size_t)layer * 9 * 6144;
  const int cond = row0 < NP ? 8 : (row0 - NP) >> 12;
  const float* gate = mod + cond * 6144 + gi * 1024 + nt * 128 + c8 * 16;
  float gv[16];
#pragma unroll
  for (int j = 0; j < 16; ++j) gv[j] = gate[j];
#pragma unroll 1
  for (int ps = 0; ps < 4; ++ps) {
    const int r = ps * 32 + (tid >> 3); const int row = row0 + r;
    float v[16]; ld16(ct, r, c8, v);
    const float* xin = from_in ? (row < NP ? p->in[0] + (size_t)row * 1024 : p->in[1] + (size_t)(row - NP) * 1024) : p->out + O_Y + (size_t)row * 1024;
    xin += nt * 128 + c8 * 16;
#pragma unroll
    for (int j = 0; j < 4; ++j) { f4 xv = *(const f4*)(xin + 4 * j); v[4 * j] = xv[0] + gv[4 * j] * v[4 * j]; v[4 * j + 1] = xv[1] + gv[4 * j + 1] * v[4 * j + 1]; v[4 * j + 2] = xv[2] + gv[4 * j + 2] * v[4 * j + 2]; v[4 * j + 3] = xv[3] + gv[4 * j + 3] * v[4 * j + 3]; }
    st16f(p->out + O_Y + (size_t)row * 1024 + nt * 128 + c8 * 16, v);
  }
}
DI void epi_ffn13(PP p, const float* ct, int row0, int nt, int tid) {
  const int j0 = (tid & 7) * 8;
  hf* t16 = (hf*)(p->ws + R1_T16);
#pragma unroll 1
  for (int ps = 0; ps < 4; ++ps) {
    const int r = ps * 32 + (tid >> 3);
    f4 a0 = *(const f4*)(ct + r * 132 + j0), a1 = *(const f4*)(ct + r * 132 + j0 + 4);
    f4 b0 = *(const f4*)(ct + r * 132 + 64 + j0), b1 = *(const f4*)(ct + r * 132 + 64 + j0 + 4);
    h8 o;
#pragma unroll
    for (int j = 0; j < 4; ++j) { o[j] = (hf)(siluf_(a0[j]) * b0[j]); o[4 + j] = (hf)(siluf_(a1[j]) * b1[j]); }
    *(h8*)(t16 + tix(row0 + r, nt * 64 + j0, NT)) = o;
  }
}

DI int gemm_ntn(int kind) { return kind == 0 ? 11 : kind == 1 ? 8 : kind == 2 ? 4 : kind == 3 ? 22 : kind == 4 ? 4 : 2; }
DI void gemm_tile_std(PP p, int kind, int layer, int t, unsigned char* smem) {
  const int tf = opaque_tid();
  const int hb = tf >> 8, tid = tf & 255;
  hf* sm = (hf*)smem; float* ct0 = (float*)smem; const float* ct = ct0 + hb * (HALF_LDS / 4);
  const hf* A; const hf* B; int K; size_t lda;
  switch (kind) {
    case 0: A = (const hf*)(p->ws + OFF_H16); lda = 1024; B = (const hf*)(p->ws + W_IN0); K = 1024; break;
    case 1: A = (const hf*)(p->ws + OFF_H16); lda = 1024; B = (const hf*)(p->ws + W_IN1); K = 1024; break;
    case 2: A = (const hf*)(p->ws + OFF_H16); lda = 1024; B = (const hf*)(p->ws + (layer ? W_OUT1 : W_OUT0)); K = 1024; break;
    case 3: A = (const hf*)(p->ws + OFF_H16); lda = 1024; B = (const hf*)(p->ws + (layer ? W_131 : W_130)); K = 1024; break;
    case 4: A = (const hf*)(p->ws + R1_T16); lda = FH; B = (const hf*)(p->ws + (layer ? W_21 : W_20)); K = FH; break;
    default: A = (const hf*)(p->ws + R1_G16); lda = 512; B = (const hf*)(p->ws + W_GLU); K = 512; break;
  }
  const int ntn = gemm_ntn(kind);
  int mt, nt2; tile_map(t, gridDim.x, 160 * ntn, ntn, mt, nt2);
  Acc acc; zero_acc(acc);
  (void)lda; LdTiled la{A, NT, mt * 256}; LdTiled lb{B, ntn * 256, nt2 * 256};
  gemm_main(acc, la, lb, K / 32, sm, tf);
  const int row0 = mt * 256 + hb * 128;
#pragma unroll 1
  for (int pass = 0; pass < 2; ++pass) {
    acc_to_lds(acc, ct0, tf, pass);
    __syncthreads();
    const int nt = nt2 * 2 + pass;
    if (kind == 0) epi_ab(p, ct, row0, nt, tid);
    else if (kind == 1) epi_cd(p, ct, row0, nt, tid);
    else if (kind == 2) epi_res(p, ct, row0, nt, tid, layer, 2, layer == 0);
    else if (kind == 3) epi_ffn13(p, ct, row0, nt, tid);
    else if (kind == 4) epi_res(p, ct, row0, nt, tid, layer, 5, false);
    else {
      const int c16 = tid & 15;
      const hf* g16 = (const hf*)(p->ws + R1_G16); hf* o16 = (hf*)(p->ws + OFF_H16);
      const int col = nt * 128 + c16 * 8;
      float bb[8];
#pragma unroll
      for (int j = 0; j < 8; ++j) bb[j] = p->in[36][col + j];
#pragma unroll 1
      for (int ps = 0; ps < 8; ++ps) {
        const int r = ps * 16 + (tid >> 4); const int row = row0 + r;
        f4 v0 = *(const f4*)(ct + r * 132 + c16 * 8), v1 = *(const f4*)(ct + r * 132 + c16 * 8 + 4);
        const h8 g0 = *(const h8*)(g16 + tix(row, col, NT));
        h8 o;
#pragma unroll
        for (int j = 0; j < 4; ++j) { o[j] = (hf)((float)g0[j] * sigmoidf_(v0[j] + bb[j])); o[4 + j] = (hf)((float)g0[4 + j] * sigmoidf_(v1[j] + bb[4 + j])); }
        *(h8*)(o16 + tix(row, col, NT)) = o;
      }
    }
    __syncthreads();
  }
}

template <int kind>
DI void gemm_phase_reg(PP p, int layer, unsigned char* smem) {
  const int tf = opaque_tid();
  hf* sm = (hf*)smem;
  const int G = gridDim.x;
  const hf* A; const hf* B; int K;
  if (kind == 2) { A = (const hf*)(p->ws + OFF_H16); B = (const hf*)(p->ws + (layer ? W_OUT1 : W_OUT0)); K = 1024; }
  else if (kind == 3) { A = (const hf*)(p->ws + OFF_H16); B = (const hf*)(p->ws + (layer ? W_131 : W_130)); K = 1024; }
  else { A = (const hf*)(p->ws + R1_T16); B = (const hf*)(p->ws + (layer ? W_21 : W_20)); K = FH; }
  const int ntn = gemm_ntn(kind), total = 160 * ntn, nk = K / 32;
  int t = opaque_s(blockIdx.x);
  if (t >= total) return;
  int mt, nt2; tile_map(t, G, total, ntn, mt, nt2);
  LdTiled la{A, NT, mt * 256}; LdTiled lb{B, ntn * 256, nt2 * 256};
  gemm_prologue(la, lb, nk, sm, tf);
  const int w = tf >> 6, l = tf & 63, wm = w >> 1, wn = w & 1;
  while (true) {
    Acc acc; zero_acc(acc);
    gemm_loop(acc, la, lb, nk, sm, tf);
    const int cmt = mt, cnt2 = nt2;
    const int tn = t + G; const bool more = tn < total;
    if (more) {
      tile_map(tn, G, total, ntn, mt, nt2);
      la.row0 = mt * 256; lb.row0 = nt2 * 256;
      gemm_prologue(la, lb, nk, sm, tf);
    }
    if (kind == 3) {
      hf* t16 = (hf*)(p->ws + R1_T16);
      const int rbase = cmt * 256 + wm * 64 + 4 * (l >> 4);
      const int hbase = (cnt2 * 2 + wn) * 64 + (l & 15);
#pragma unroll
      for (int m = 0; m < 4; ++m) {
#pragma unroll
        for (int i = 0; i < 4; ++i) {
          hf* tp = t16 + tix(rbase + m * 16 + i, hbase, NT);
          tp[0] = (hf)(siluf_(acc.v[m][0][i]) * acc.v[m][4][i]);
          tp[16] = (hf)(siluf_(acc.v[m][1][i]) * acc.v[m][5][i]);
          tp[(size_t)NT * 32] = (hf)(siluf_(acc.v[m][2][i]) * acc.v[m][6][i]);
          tp[(size_t)NT * 32 + 16] = (hf)(siluf_(acc.v[m][3][i]) * acc.v[m][7][i]);
        }
        __builtin_amdgcn_sched_barrier(0);
      }
    }
    if (!more) break;
    t = tn;
  }
  asm volatile("s_waitcnt vmcnt(0)" ::: "memory");
  __syncthreads();
}

DI void s5_prep_item(PP p, int it, unsigned char* smem) {
  const int tf = opaque_tid(); const int half = tf >> 8; const int tid = tf & 255; smem += half * HALF_LDS; it = 2 * it + half;
  const int g = it >> 6, j = it & 63;
  float* W = (float*)smem;
  if (tid < 128) {
    const int d = tid >> 6, pp = tid & 63;
    const double lr = (double)p->in[27][(d * 32 + g) * 64 + pp], li = (double)p->in[28][(d * 32 + g) * 64 + pp];
    const double dt = exp((double)p->in[29][d * 32 + g]);
    double ar, ai; cpowd(lr, li, dt, 1, ar, ai);
    const double den = lr * lr + li * li;
    const double fr = ((ar - 1.0) * lr + ai * li) / den, fi = (ai * lr - (ar - 1.0) * li) / den;
    double xr, xi;
    cpowd(lr, li, dt, j, xr, xi);
    W[(d * 64 + pp) * 2] = (float)(xr * fr - xi * fi); W[(d * 64 + pp) * 2 + 1] = (float)(xr * fi + xi * fr);
    if (d == 0) {
      cpowd(lr, li, dt, 63 - j, xr, xi);
      W[(2 * 64 + pp) * 2] = (float)(xr * fr - xi * fi); W[(2 * 64 + pp) * 2 + 1] = (float)(xr * fi + xi * fr);
      cpowd(lr, li, dt, j + 1, xr, xi);
      W[(3 * 64 + pp) * 2] = (float)xr; W[(3 * 64 + pp) * 2 + 1] = (float)xi;
    } else {
      cpowd(lr, li, dt, 64 - j, xr, xi);
      W[(4 * 64 + pp) * 2] = (float)xr; W[(4 * 64 + pp) * 2 + 1] = (float)xi;
    }
  }
  __syncthreads();
  const float* cre = p->in[32] + (size_t)g * 1024; const float* cim = p->in[33] + (size_t)g * 1024;
  const float* bre = p->in[30] + (size_t)g * 1024; const float* bim = p->in[31] + (size_t)g * 1024;
  {
    const int co = tid >> 4, ci = tid & 15;
    float kf = 0.f, kb = 0.f;
    for (int pp = 0; pp < 64; ++pp) {
      const float cr = cre[co * 64 + pp], cm = cim[co * 64 + pp], br = bre[pp * 16 + ci], bm = bim[pp * 16 + ci];
      const float wfr = W[pp * 2], wfi = W[pp * 2 + 1], wbr = W[(64 + pp) * 2], wbi = W[(64 + pp) * 2 + 1];
      kf += (cr * wfr - cm * wfi) * br - (cr * wfi + cm * wfr) * bm;
      kb += (cr * wbr - cm * wbi) * br - (cr * wbi + cm * wbr) * bm;
    }
    hf* kc = (hf*)(p->ws + R2_KC) + (size_t)g * 127 * 256;
    if (j == 0) kc[63 * 256 + tid] = (hf)((kf + kb) * KSC);
    else { kc[(63 + j) * 256 + tid] = (hf)(kf * KSC); kc[(63 - j) * 256 + tid] = (hf)(kb * KSC); }
  }
  {
    const int pp = tid >> 2, ci0 = (tid & 3) * 4;
    hf* E = (hf*)(p->ws + R2_E) + (size_t)g * 256 * 1024;
    const float efr = W[(2 * 64 + pp) * 2], efi = W[(2 * 64 + pp) * 2 + 1], ebr = W[(64 + pp) * 2], ebi = W[(64 + pp) * 2 + 1];
    h4 o0, o1, o2, o3;
#pragma unroll
    for (int c = 0; c < 4; ++c) {
      const float br = bre[pp * 16 + ci0 + c], bm = bim[pp * 16 + ci0 + c];
      o0[c] = (hf)(efr * br - efi * bm); o1[c] = (hf)(efr * bm + efi * br);
      o2[c] = (hf)(ebr * br - ebi * bm); o3[c] = (hf)(ebr * bm + ebi * br);
    }
    *(h4*)(E + tix(0 + pp, j * 16 + ci0, 256)) = o0;
    *(h4*)(E + tix(64 + pp, j * 16 + ci0, 256)) = o1;
    *(h4*)(E + tix(128 + pp, j * 16 + ci0, 256)) = o2;
    *(h4*)(E + tix(192 + pp, j * 16 + ci0, 256)) = o3;
  }
  {
    const int co = tid >> 4, p0 = (tid & 15) * 4;
    hf* F = (hf*)(p->ws + R2_FC) + (size_t)g * 1024 * 256; const int frow = j * 16 + co;
    h4 o0, o1, o2, o3;
#pragma unroll
    for (int c = 0; c < 4; ++c) {
      const int pp = p0 + c;
      const float cr = cre[co * 64 + pp], cm = cim[co * 64 + pp];
      const float afr = W[(3 * 64 + pp) * 2], afi = W[(3 * 64 + pp) * 2 + 1], abr = W[(4 * 64 + pp) * 2], abi = W[(4 * 64 + pp) * 2 + 1];
      o0[c] = (hf)((cr * afr - cm * afi) * KSC); o1[c] = (hf)((-cr * afi - cm * afr) * KSC);
      o2[c] = (hf)((cr * abr - cm * abi) * KSC); o3[c] = (hf)((-cr * abi - cm * abr) * KSC);
    }
    *(h4*)(F + tix(frow, p0, 1024)) = o0; *(h4*)(F + tix(frow, 64 + p0, 1024)) = o1; *(h4*)(F + tix(frow, 128 + p0, 1024)) = o2; *(h4*)(F + tix(frow, 192 + p0, 1024)) = o3;
  }
  __syncthreads();
}

DI void s5_egemm_tile(PP p, int t, unsigned char* smem) {
  const int tf = opaque_tid();
  const int hb = tf >> 8, tid = tf & 255;
  hf* sm = (hf*)smem; float* ct0 = (float*)smem; const float* ct = ct0 + hb * (HALF_LDS / 4);
  const int g = t / 3, mt = t % 3;
  Acc acc; zero_acc(acc);
  LdTiled la{(const hf*)(p->ws + R1_UG) + (size_t)g * NT * 16, 640, mt * 256};
  LdTiled lb{(const hf*)(p->ws + R2_E) + (size_t)g * 256 * 1024, 256, 0};
  gemm_main(acc, la, lb, 32, sm, tf);
  const int c8 = tid & 7;
  float* Sc = (float*)(p->ws + R2_SC);
#pragma unroll 1
  for (int pass = 0; pass < 2; ++pass) {
    acc_to_lds(acc, ct0, tf, pass);
    __syncthreads();
#pragma unroll 1
    for (int ps = 0; ps < 4; ++ps) {
      const int rr = ps * 32 + (tid >> 3);
      const int n = mt * 256 + hb * 128 + rr;
      float v[16]; ld16(ct, rr, c8, v);
      if (n < 640) st16f(Sc + ((size_t)g * 640 + n) * 256 + pass * 128 + c8 * 16, v);
    }
    __syncthreads();
  }
}
DI void s5_ygemm_tile(PP p, int t, unsigned char* smem) {
  const int tf = opaque_tid();
  const int hb = tf >> 8, tid = tf & 255;
  hf* sm = (hf*)smem; float* ct0 = (float*)smem; const float* ct = ct0 + hb * (HALF_LDS / 4);
  const int g = t / 12, r = t % 12, mt = r >> 2, nt2 = r & 3;
  Acc acc; zero_acc(acc);
  {
    LdTiled la{(const hf*)(p->ws + R1_UG) + (size_t)g * NT * 16, 640, mt * 256};
    LdToep lb{(const hf*)(p->ws + R2_KC) + (size_t)g * 127 * 256, nt2 * 256};
    gemm_main(acc, la, lb, 32, sm, tf);
  }
  {
    LdTiled la{(const hf*)(p->ws + R2_H) + (size_t)g * 640 * 256, 640, mt * 256};
    LdTiled lb{(const hf*)(p->ws + R2_FC) + (size_t)g * 1024 * 256, 1024, nt2 * 256};
    gemm_main(acc, la, lb, 8, sm, tf);
  }
  const int c8 = tid & 7;
  const hf* ug = (const hf*)(p->ws + R1_UG) + (size_t)g * NT * 16;
  hf* g16 = (hf*)(p->ws + R1_G16);
  const float* dsk = p->in[34] + g * 16;
#pragma unroll 1
  for (int pass = 0; pass < 2; ++pass) {
    acc_to_lds(acc, ct0, tf, pass);
    __syncthreads();
#pragma unroll 1
    for (int ps = 0; ps < 4; ++ps) {
      const int rr = ps * 32 + (tid >> 3);
      const int n = mt * 256 + hb * 128 + rr;
      float v[16]; ld16(ct, rr, c8, v);
      if (n < 640) {
        const int tok = n * 64 + (nt2 * 2 + pass) * 8 + c8;
        const hf* up = ug + tix(tok >> 6, (tok & 63) * 16, 640);
        h8 u0 = *(const h8*)up, u1 = *(const h8*)(up + 8);
#pragma unroll
        for (int jj = 0; jj < 8; ++jj) {
          v[jj] = gelu_tanh(v[jj] * (1.f / KSC) + dsk[jj] * (float)u0[jj]);
          v[8 + jj] = gelu_tanh(v[8 + jj] * (1.f / KSC) + dsk[8 + jj] * (float)u1[jj]);
        }
        st16h(g16 + tix(tok, g * 16, NT), v);
      }
    }
    __syncthreads();
  }
}
DI void s5_scan_item(PP p, int it) {
  const int tf = opaque_tid(); const int half = tf >> 8; const int tid = tf & 255; it = 2 * it + half;
  const int gblk = it & 7, dir = (it >> 3) & 1, seq = it >> 4;
  const int g = gblk * 4 + (tid >> 6), pp = tid & 63;
  float ar, ai;
  {
    double ard, aid;
    cpowd((double)p->in[27][(dir * 32 + g) * 64 + pp], (double)p->in[28][(dir * 32 + g) * 64 + pp], exp((double)p->in[29][dir * 32 + g]), 64, ard, aid);
    ar = (float)ard; ai = (float)aid;
  }
  int n0, nch; float sr = 0.f, si = 0.f;
  if (seq < 32) { n0 = seq * 4; nch = 4; }
  else { const int b = seq - 32; n0 = 128 + b * 64; nch = 64; sr = p->in[7][((b * 2 + dir) * 32 + g) * 64 + pp]; si = p->in[8][((b * 2 + dir) * 32 + g) * 64 + pp]; }
  const float* Sc = (const float*)(p->ws + R2_SC) + (size_t)g * 640 * 256 + dir * 128 + pp;
  hf* H = (hf*)(p->ws + R2_H) + (size_t)g * 640 * 256;
#pragma unroll 4
  for (int c = 0; c < nch; ++c) {
    const int n = dir == 0 ? n0 + c : n0 + nch - 1 - c;
    const float xr = Sc[(size_t)n * 256], xi = Sc[(size_t)n * 256 + 64];
    H[tix(n, dir * 128 + pp, 640)] = (hf)sr; H[tix(n, dir * 128 + 64 + pp, 640)] = (hf)si;
    const float nr = ar * sr - ai * si + xr, ni = ar * si + ai * sr + xi;
    sr = nr; si = ni;
  }
  if (seq < 32) {
    p->out[O_SRE + ((size_t)(seq * 2 + dir) * 32 + g) * 64 + pp] = sr;
    p->out[O_SIM + ((size_t)(seq * 2 + dir) * 32 + g) * 64 + pp] = si;
  }
}

DI void attn_a_item(PP p, int it, unsigned char* smem) {
  const int tf = opaque_tid(); const int half = tf >> 8; const int tid = tf & 255; smem += half * HALF_LDS; it = 2 * it + half;
  int row0, h; KVSeg s0, s1; int qpos0 = 0;
  const hf* ka = (const hf*)(p->ws + R1_KA); const hf* va = (const hf*)(p->ws + R1_VA);
  if (it < 2048) {
    const int b = it >> 8, qb = (it >> 3) & 31; h = it & 7; const int g = h >> 2;
    row0 = NP + b * 4096 + qb * 128;
    s0.K = (const hf*)(p->ws + M_CKA) + (size_t)((b * 2 + g) * 256) * 64; s0.V = (const hf*)(p->ws + M_CVA) + (size_t)((b * 2 + g) * 256) * 64;
    s0.kld = 64; s0.vld = 64; s0.ntiles = 4; s0.kpos0 = 0;
    int ks = qb * 128 - 128, ke = qb * 128 + 256; if (ks < 0) ks = 0; if (ke > 4096) ke = 4096;
    s1.K = ka + (size_t)(NP + b * 4096 + ks) * 128 + g * 64; s1.V = va + (size_t)(NP + b * 4096 + ks) * 128 + g * 64;
    s1.kld = 128; s1.vld = 128; s1.ntiles = (ke - ks) >> 6; s1.kpos0 = ks; qpos0 = qb * 128;
  } else {
    const int t = it - 2048; const int b = t >> 4, qb = (t >> 3) & 1; h = t & 7; const int g = h >> 2;
    row0 = b * 256 + qb * 128;
    s0.K = ka + (size_t)(b * 256) * 128 + g * 64; s0.V = va + (size_t)(b * 256) * 128 + g * 64;
    s0.kld = 128; s0.vld = 128; s0.ntiles = 4; s0.kpos0 = 0;
    s1 = s0; s1.ntiles = 0;
  }
  f16v O[2];
  const float sink = p->in[22][h] * LOG2E;
  attn_run<64>(O, (const hf*)(p->ws + R1_QA) + (size_t)row0 * 512 + h * 64, 512, s0, s1, sink, 1.f, qpos0, true, (hf*)smem, tid);
  const int w = tid >> 6, l = tid & 63, lr32 = l & 31, hh = l >> 5;
  hf* o16 = (hf*)(p->ws + OFF_H16);
  const int orow = row0 + w * 32 + lr32;
#pragma unroll
  for (int d = 0; d < 2; ++d)
#pragma unroll
    for (int gq = 0; gq < 4; ++gq) {
      h4 o; o[0] = (hf)O[d][4 * gq]; o[1] = (hf)O[d][4 * gq + 1]; o[2] = (hf)O[d][4 * gq + 2]; o[3] = (hf)O[d][4 * gq + 3];
      *(h4*)(o16 + tix(orow, h * 64 + d * 32 + 8 * gq + 4 * hh, NT)) = o;
    }
}

DI void attn_d_item(PP p, int it, unsigned char* smem) {
  const int tf = opaque_tid(); const int half = tf >> 8; const int tid = tf & 255; smem += half * HALF_LDS; it = 2 * it + half;
  const hf* kd = (const hf*)(p->ws + R1_KD); const hf* vd = (const hf*)(p->ws + R1_VD);
  int row0, h, b; bool sample;
  if (it < 1024) { b = it >> 7; const int qb = (it >> 2) & 31; h = it & 3; row0 = NP + b * 4096 + qb * 128; sample = true; }
  else { const int t = it - 1024; b = t >> 3; const int qb = (t >> 2) & 1; h = t & 3; row0 = b * 256 + qb * 128; sample = false; }
  const float lam = ((const float*)(p->ws + M_SCAL))[0];
  const int w = tid >> 6, l = tid & 63, lr32 = l & 31, hh = l >> 5;
  hf* o16 = (hf*)(p->ws + OFF_H16);
  const int orow = row0 + w * 32 + lr32, ocol = 512 + h * 128;
  f16v O[4];
#pragma unroll 1
  for (int c = 0; c < 2; ++c) {
    KVSeg s0, s1;
    if (sample) {
      s0.K = (const hf*)(p->ws + M_CKD) + (size_t)(((b * 4 + h) * 2 + c) * 256) * 64; s0.V = (const hf*)(p->ws + M_CVD) + (size_t)((b * 4 + h) * 256) * 128;
      s0.kld = 64; s0.vld = 128; s0.ntiles = 4; s0.kpos0 = 0;
      s1.K = kd + (size_t)(NP + b * 4096) * 512 + h * 128 + c * 64; s1.V = vd + (size_t)(NP + b * 4096) * 512 + h * 128;
      s1.kld = 512; s1.vld = 512; s1.ntiles = 64; s1.kpos0 = 0;
    } else {
      s0.K = kd + (size_t)(b * 256) * 512 + h * 128 + c * 64; s0.V = vd + (size_t)(b * 256) * 512 + h * 128;
      s0.kld = 512; s0.vld = 512; s0.ntiles = 4; s0.kpos0 = 0;
      s1 = s0; s1.ntiles = 0;
    }
    attn_run<128>(O, (const hf*)(p->ws + R1_QD) + (size_t)row0 * 512 + h * 128 + c * 64, 512, s0, s1, NEGBIG, 0.f, 0, false, (hf*)smem, tid);
    if (c == 0) {
#pragma unroll
      for (int d = 0; d < 4; ++d)
#pragma unroll
        for (int gq = 0; gq < 4; ++gq) {
          h4 o; o[0] = (hf)O[d][4 * gq]; o[1] = (hf)O[d][4 * gq + 1]; o[2] = (hf)O[d][4 * gq + 2]; o[3] = (hf)O[d][4 * gq + 3];
          *(h4*)(o16 + tix(orow, ocol + d * 32 + 8 * gq + 4 * hh, NT)) = o;
        }
    }
  }
  float ss = 0.f;
#pragma unroll
  for (int d = 0; d < 4; ++d)
#pragma unroll
    for (int gq = 0; gq < 4; ++gq) {
      h4 o0 = *(const h4*)(o16 + tix(orow, ocol + d * 32 + 8 * gq + 4 * hh, NT));
#pragma unroll
      for (int r = 0; r < 4; ++r) { float x = (float)o0[r] - lam * O[d][4 * gq + r]; O[d][4 * gq + r] = x; ss += x * x; }
    }
  ss += __shfl_xor(ss, 32);
  const float rstd = rsqrtf(ss * (1.f / 128.f) + 1e-6f) * (1.f - 0.35550906759096994f);
  const float* sg = p->in[40];
#pragma unroll
  for (int d = 0; d < 4; ++d)
#pragma unroll
    for (int gq = 0; gq < 4; ++gq) {
      const int dv0 = d * 32 + 8 * gq + 4 * hh;
      h4 o;
#pragma unroll
      for (int r = 0; r < 4; ++r) o[r] = (hf)(O[d][4 * gq + r] * rstd * sg[dv0 + r]);
      *(h4*)(o16 + tix(orow, ocol + dv0, NT)) = o;
    }
}

DI void ret_kv_item(PP p, int it, unsigned char* smem) {
  const int tf = opaque_tid(); const int half = tf >> 8; const int tid = tf & 255; smem += half * HALF_LDS; it = 2 * it + half;
  const int cg_ = it >> 3, h = it & 7;
  const float* lgt = (const float*)(p->ws + M_SCAL) + 16;
  const float lgf2 = lgt[h] * LOG2E, lgb2 = lgt[8 + h] * LOG2E;
  hf* sKf = (hf*)smem; hf* sKb = sKf + 128 * 72; hf* sV = sKb + 128 * 72;
  const hf* kb = (const hf*)(p->ws + R1_KB) + (size_t)cg_ * 128 * 512 + h * 64;
  const hf* vb = (const hf*)(p->ws + R1_VB) + (size_t)cg_ * 128 * 512 + h * 64;
  const int kr = tid >> 3, kc = (tid & 7) * 8;
#pragma unroll
  for (int i = 0; i < 4; ++i) {
    const int r = kr + 32 * i;
    h8 kv = *(const h8*)(kb + (size_t)r * 512 + kc), vv = *(const h8*)(vb + (size_t)r * 512 + kc);
    const hf df = (hf)ex2(lgf2 * (float)(127 - r)), db = (hf)ex2(lgb2 * (float)r);
    h8 kf, kbv;
#pragma unroll
    for (int j = 0; j < 8; ++j) { kf[j] = kv[j] * df; kbv[j] = kv[j] * db; }
    *(h8*)(sKf + r * 72 + kc) = kf; *(h8*)(sKb + r * 72 + kc) = kbv; *(h8*)(sV + r * 72 + kc) = vv;
  }
  __syncthreads();
  const int w = tid >> 6, l = tid & 63, lr32 = l & 31, hh = l >> 5;
  const int dir = w >> 1, dvb = w & 1;
  const hf* sKx = dir ? sKb : sKf;
  const int i16 = l & 15, q4 = i16 >> 2, p4 = i16 & 3, blk = (l >> 4) & 1;
  const int toff = (8 * hh + q4) * 72 + 16 * blk + 4 * p4;
  f16v acc[2]; acc[0] = zero16(); acc[1] = zero16();
#pragma unroll
  for (int k0 = 0; k0 < 8; ++k0) {
    const hf* vp = sV + k0 * 16 * 72 + toff + dvb * 32;
    h8 af = cat8(trread(vp), trread(vp + 4 * 72));
#pragma unroll
    for (int dkb = 0; dkb < 2; ++dkb) {
      const hf* kp = sKx + k0 * 16 * 72 + toff + dkb * 32;
      h8 bf = cat8(trread(kp), trread(kp + 4 * 72));
      acc[dkb] = MFMA(af, bf, acc[dkb]);
    }
  }
  float* kvc = (float*)(p->ws + R2_KVC) + ((size_t)(cg_ * 8 + h) * 2 + dir) * 4096;
#pragma unroll
  for (int dkb = 0; dkb < 2; ++dkb)
#pragma unroll
    for (int e = 0; e < 16; ++e) kvc[(dvb * 32 + crow(e, hh)) * 64 + dkb * 32 + lr32] = acc[dkb][e];
  __syncthreads();
}

DI void ret_scan_item(PP p, int it, unsigned char* smem) {
  const int tf = opaque_tid(); const int half = tf >> 8; const int tid = tf & 255; smem += half * HALF_LDS; it = 2 * it + half;
  const int dir = it & 1, h = (it >> 1) & 7, seq = it >> 4;
  const float lg = ((const float*)(p->ws + M_SCAL))[16 + dir * 8 + h];
  const float cd = __expf(lg * 128.f);
  int c0, nch; float st[16];
  if (seq < 32) {
    c0 = seq * 2; nch = 2;
#pragma unroll
    for (int i = 0; i < 16; ++i) st[i] = 0.f;
  } else {
    const int b = seq - 32; c0 = 64 + b * 32; nch = 32;
    const float* s0 = p->in[6] + ((size_t)(b * 2 + dir) * 8 + h) * 4096;
#pragma unroll
    for (int i = 0; i < 16; ++i) { const int e = tid + 256 * i; st[i] = s0[(e & 63) * 64 + (e >> 6)]; }
  }
  const float* kvc = (const float*)(p->ws + R2_KVC);
  hf* stt = (hf*)(p->ws + R2_STT);
#pragma unroll 1
  for (int c = 0; c < nch; ++c) {
    const int cgi = dir == 0 ? c0 + c : c0 + nch - 1 - c;
    const size_t base = ((size_t)(cgi * 8 + h) * 2 + dir) * 4096;
#pragma unroll
    for (int i = 0; i < 16; ++i) { const int e = tid + 256 * i; stt[base + e] = (hf)st[i]; st[i] = cd * st[i] + kvc[base + e]; }
  }
  if (seq < 32) {
    float* tile = (float*)smem;
#pragma unroll
    for (int i = 0; i < 16; ++i) { const int e = tid + 256 * i; tile[(e >> 6) * 65 + (e & 63)] = st[i]; }
    __syncthreads();
    float* o = p->out + O_RET + ((size_t)(seq * 2 + dir) * 8 + h) * 4096;
#pragma unroll
    for (int i = 0; i < 16; ++i) { const int e = tid + 256 * i; o[e] = tile[(e & 63) * 65 + (e >> 6)]; }
    __syncthreads();
  }
}

DI void ret_out_item(PP p, int it, unsigned char* smem) {
  const int tf = opaque_tid(); const int half = tf >> 8; const int tid = tf & 255; smem += half * HALF_LDS; it = 2 * it + half;
  const int cg_ = it >> 3, h = it & 7;
  const float* lgt = (const float*)(p->ws + M_SCAL) + 16;
  const float lgf2 = lgt[h] * LOG2E, lgb2 = lgt[8 + h] * LOG2E;
  hf* sK = (hf*)smem; hf* sV = sK + 128 * 72;
  const int row0 = cg_ * 128;
  const hf* kb = (const hf*)(p->ws + R1_KB) + (size_t)row0 * 512 + h * 64;
  const hf* vb = (const hf*)(p->ws + R1_VB) + (size_t)row0 * 512 + h * 64;
  const int kr = tid >> 3, kc = (tid & 7) * 8;
#pragma unroll
  for (int i = 0; i < 4; ++i) {
    const int r = kr + 32 * i;
    *(h8*)(sK + r * 72 + kc) = *(const h8*)(kb + (size_t)r * 512 + kc);
    *(h8*)(sV + r * 96 + kc) = *(const h8*)(vb + (size_t)r * 512 + kc);
  }
  const int w = tid >> 6, l = tid & 63, lr32 = l & 31, hh = l >> 5;
  h8 qf[4];
  {
    const hf* qp = (const hf*)(p->ws + R1_QB) + (size_t)(row0 + w * 32 + lr32) * 512 + h * 64 + 8 * hh;
#pragma unroll
    for (int ks = 0; ks < 4; ++ks) qf[ks] = *(const h8*)(qp + ks * 16);
  }
  __syncthreads();
  const int i16 = l & 15, q4 = i16 >> 2, p4 = i16 & 3, blk = (l >> 4) & 1;
  const int voff = (4 * hh + q4) * 96 + 16 * blk + 4 * p4;
  const int iq = w * 32 + lr32;
  f16v O[2]; O[0] = zero16(); O[1] = zero16();
#pragma unroll 1
  for (int kbk = 0; kbk < 4; ++kbk) {
    f16v st = zero16();
    const hf* kp = sK + (kbk * 32 + lr32) * 72 + 8 * hh;
#pragma unroll
    for (int ks = 0; ks < 4; ++ks) { h8 kf = *(const h8*)(kp + ks * 16); st = MFMA(kf, qf[ks], st); }
#pragma unroll
    for (int e = 0; e < 16; ++e) {
      const int j = kbk * 32 + crow(e, hh); const int d = iq - j;
      const float dec = d > 0 ? ex2(lgf2 * (float)d) : (d < 0 ? ex2(lgb2 * (float)(-d)) : 2.f);
      st[e] *= dec;
    }
#pragma unroll
    for (int s = 0; s < 2; ++s) {
      const h8 pf = pack8(st, s);
      const hf* vp = sV + (kbk * 32 + 16 * s) * 96 + voff;
#pragma unroll
      for (int d = 0; d < 2; ++d) { h8 vf = cat8(trread(vp + d * 32), trread(vp + 8 * 96 + d * 32)); O[d] = MFMA(vf, pf, O[d]); }
    }
  }
  const hf* stt = (const hf*)(p->ws + R2_STT) + (size_t)(cg_ * 8 + h) * 2 * 4096;
  f16v cf[2], cb[2];
#pragma unroll
  for (int d = 0; d < 2; ++d) {
    cf[d] = zero16(); cb[d] = zero16();
#pragma unroll
    for (int ks = 0; ks < 4; ++ks) {
      h8 af = *(const h8*)(stt + (d * 32 + lr32) * 64 + ks * 16 + 8 * hh);
      h8 ab = *(const h8*)(stt + 4096 + (d * 32 + lr32) * 64 + ks * 16 + 8 * hh);
      cf[d] = MFMA(af, qf[ks], cf[d]); cb[d] = MFMA(ab, qf[ks], cb[d]);
    }
  }
  const float qsf = ex2(lgf2 * (float)(iq + 1)), qsb = ex2(lgb2 * (float)(128 - iq));
  float ss = 0.f;
#pragma unroll
  for (int d = 0; d < 2; ++d)
#pragma unroll
    for (int e = 0; e < 16; ++e) { float x = O[d][e] + qsf * cf[d][e] + qsb * cb[d][e]; O[d][e] = x; ss += x * x; }
  ss += __shfl_xor(ss, 32);
  const float rstd = rsqrtf(ss * (1.f / 64.f) + 1e-6f);
  const int row = row0 + iq;
  const hf* gb = (const hf*)(p->ws + R1_GB) + (size_t)row * 512 + h * 64;
  hf* o16 = (hf*)(p->ws + OFF_H16);
  const float* rg = p->in[24];
#pragma unroll
  for (int d = 0; d < 2; ++d)
#pragma unroll
    for (int gq = 0; gq < 4; ++gq) {
      const int dv0 = d * 32 + 8 * gq + 4 * hh;
      h4 gv = *(const h4*)(gb + dv0);
      h4 o;
#pragma unroll
      for (int r = 0; r < 4; ++r) o[r] = (hf)(O[d][4 * gq + r] * rstd * rg[dv0 + r] * siluf_((float)gv[r]));
      *(h4*)(o16 + tix(row, 512 + h * 64 + dv0, NT)) = o;
    }
  __syncthreads();
}


#define XB_TMO      128
#define XB_XCNT(j)  (256  + 64 * (j))
#define XB_XSUB(j)  (1280 + 64 * (j))
#define XB_XGEN(j)  (2304 + 64 * (j))
#define XB_TOP      3328
#define XB_TOPGEN   3392
#define XCD_BAR_WORDS 3456
#define XB_SPIN_CAP (1u << 18)
#define LAS __attribute__((address_space(3)))
DI unsigned xb_ld(unsigned* p) { return __hip_atomic_load(p, __ATOMIC_RELAXED, __HIP_MEMORY_SCOPE_AGENT); }
DI unsigned xb_add(unsigned* p, unsigned v) { return __hip_atomic_fetch_add(p, v, __ATOMIC_RELAXED, __HIP_MEMORY_SCOPE_AGENT); }
DI unsigned xb_xcc_id() { return (unsigned)__builtin_amdgcn_s_getreg((3 << 11) | 20) & 0xFu; }
#define XB_SPIN(cond, bar) do { unsigned _sp = 0; while (cond) { __builtin_amdgcn_s_sleep(1); \
    if ((++_sp & 255u) == 0u) { if (xb_ld(&(bar)[XB_TMO])) break; if (_sp > XB_SPIN_CAP) { atomicAdd(&(bar)[XB_TMO], 1u); break; } } } } while (0)
struct XcdBarrier { unsigned* bar; unsigned x; volatile LAS unsigned* st; };
DI XcdBarrier xcd_barrier_post(unsigned* bar, volatile LAS unsigned* st) {
  XcdBarrier b; b.bar = bar; b.x = xb_xcc_id(); b.st = st;
  if (threadIdx.x == 0) (void)xb_add(&bar[XB_XCNT(b.x)], 1u);
  return b;
}
DI void xcd_barrier_complete(unsigned* bar, unsigned x, unsigned& nloc, unsigned& nx) {
  const unsigned G = gridDim.x * gridDim.y * gridDim.z;
  unsigned sum, cnt, mine, sp = 0u;
  for (;;) {
    sum = 0u; cnt = 0u; mine = 0u;
#pragma unroll
    for (unsigned j = 0; j < 16; ++j) { const unsigned c = xb_ld(&bar[XB_XCNT(j)]); sum += c; cnt += (c > 0u) ? 1u : 0u; mine = (j == x) ? c : mine; }
    if (sum == G) break;
    __builtin_amdgcn_s_sleep(1);
    if ((++sp & 255u) == 0u) { if (xb_ld(&bar[XB_TMO])) break; if (sp > XB_SPIN_CAP) { atomicAdd(&bar[XB_TMO], 1u); break; } }
  }
  nloc = mine > 0u ? mine : 1u; nx = cnt > 0u ? cnt : 1u;
}
DI void xcd_barrier(const XcdBarrier& b) {
  asm volatile("s_waitcnt vmcnt(0)" ::: "memory");
  __syncthreads();
  if (threadIdx.x == 0) {
    unsigned* bar = b.bar;
    __builtin_amdgcn_s_waitcnt(0);
    unsigned nloc = b.st[0], nx = b.st[1];
    if (nloc == 0u) { xcd_barrier_complete(bar, b.x, nloc, nx); b.st[0] = nloc; b.st[1] = nx; }
    const unsigned old = xb_add(&bar[XB_XSUB(b.x)], 1u);
    const unsigned gen = old / nloc;
    if (old + 1u == (gen + 1u) * nloc) {
      __builtin_amdgcn_fence(__ATOMIC_RELEASE, "agent");
      asm volatile("s_waitcnt vmcnt(0)" ::: "memory");
      const unsigned og = xb_add(&bar[XB_TOP], 1u);
      const unsigned tg = og / nx;
      if (og + 1u == (tg + 1u) * nx) xb_add(&bar[XB_TOPGEN], 1u);
      else XB_SPIN(xb_ld(&bar[XB_TOPGEN]) == tg, bar);
      __builtin_amdgcn_fence(__ATOMIC_ACQUIRE, "agent");
      xb_add(&bar[XB_XGEN(b.x)], 1u);
      asm volatile("s_waitcnt vmcnt(0)" ::: "memory");
    } else {
      XB_SPIN(xb_ld(&bar[XB_XGEN(b.x)]) == gen, bar);
      __builtin_amdgcn_fence(__ATOMIC_ACQUIRE, "agent");
      asm volatile("s_waitcnt vmcnt(0)" ::: "memory");
    }
  }
  __syncthreads();
}

constexpr int NPHASE = 20;

template <int ph>
DI void run_phase(PP p0, unsigned char* smem) {
  PP p = opaque_p(p0);
  const int G = opaque_s(gridDim.x), bid = opaque_s(blockIdx.x);
  if constexpr (ph == 0) phase_prep<0>(p, smem);
  else if constexpr (ph == 1) phase_norm(p, 0, 0);
  else if constexpr (ph == 2) { for (int t = bid; t < 160 * 11; t += G) gemm_tile_std(p, 0, 0, t, smem); }
  else if constexpr (ph == 3) { for (int t = bid; t < 1280 + 1280; t += G) { if (t < 1280) attn_a_item(p, t, smem); else ret_kv_item(p, t - 1280, smem); } }
  else if constexpr (ph == 4) { for (int t = bid; t < 320; t += G) ret_scan_item(p, 319 - t, smem); }
  else if constexpr (ph == 5) { for (int t = bid; t < 1280; t += G) ret_out_item(p, t, smem); }
  else if constexpr (ph == 6) { for (int t = bid; t < 160 * 4; t += G) gemm_tile_std(p, 2, 0, t, smem); phase_prep<1>(p, smem); }
  else if constexpr (ph == 7) phase_norm(p, 0, 1);
  else if constexpr (ph == 8) gemm_phase_reg<3>(p, 0, smem);
  else if constexpr (ph == 9) {
    for (int t = bid; t < 160 * 4; t += G) gemm_tile_std(p, 4, 0, t, smem);
    if (bid >= (G >> 1)) { for (int t = bid - (G >> 1); t < 1024; t += G - (G >> 1)) s5_prep_item(p, t, smem); }
  }
  else if constexpr (ph == 10) phase_norm(p, 1, 0);
  else if constexpr (ph == 11) { for (int t = bid; t < 160 * 8; t += G) gemm_tile_std(p, 1, 1, t, smem); }
  else if constexpr (ph == 12) { for (int t = bid; t < 640 + 96; t += G) { if (t < 640) attn_d_item(p, t, smem); else s5_egemm_tile(p, t - 640, smem); } }
  else if constexpr (ph == 13) { for (int t = bid; t < 320; t += G) s5_scan_item(p, 319 - t); }
  else if constexpr (ph == 14) { for (int t = bid; t < 384; t += G) s5_ygemm_tile(p, t, smem); }
  else if constexpr (ph == 15) { for (int t = bid; t < 160 * 2; t += G) gemm_tile_std(p, 5, 1, t, smem); }
  else if constexpr (ph == 16) { for (int t = bid; t < 160 * 4; t += G) gemm_tile_std(p, 2, 1, t, smem); phase_prep<2>(p, smem); }
  else if constexpr (ph == 17) phase_norm(p, 1, 1);
  else if constexpr (ph == 18) gemm_phase_reg<3>(p, 1, smem);
  else { for (int t = bid; t < 160 * 4; t += G) gemm_tile_std(p, 4, 1, t, smem); }
}

#ifndef REPEAT_MASK
#define REPEAT_MASK 0u
#endif
template <int ph>
DI void do_phase(PP p, int ph_lo, int ph_hi, unsigned char* smem, cg::grid_group& grid, const XcdBarrier& xb) {
  if (ph_lo <= ph && ph < ph_hi) {
    run_phase<ph>(p, smem);
    if constexpr (((REPEAT_MASK >> ph) & 1u) != 0u) { grid.sync(); run_phase<ph>(p, smem); }
    if (ph + 1 < ph_hi) {
      if (ph_lo < 0) grid.sync();
      xcd_barrier(xb);
    }
  }
}

__global__ void __launch_bounds__(512) mega(P p_arg, int ph_lo, int ph_hi) {
  extern __shared__ __attribute__((aligned(16))) unsigned char smem[];
  PP p = (PP)__builtin_amdgcn_kernarg_segment_ptr();
  cg::grid_group grid = cg::this_grid();
  if ((threadIdx.x >> 6) >= 4) __builtin_amdgcn_s_setprio(1);
  volatile LAS unsigned* st = (volatile LAS unsigned*)(smem + LDS_BYTES);
  if (threadIdx.x < 2) st[threadIdx.x] = 0u;
  __syncthreads();
  const XcdBarrier xb = xcd_barrier_post((unsigned*)(p->ws + M_BAR), st);
  do_phase<0>(p, ph_lo, ph_hi, smem, grid, xb);
  do_phase<1>(p, ph_lo, ph_hi, smem, grid, xb);
  do_phase<2>(p, ph_lo, ph_hi, smem, grid, xb);
  do_phase<3>(p, ph_lo, ph_hi, smem, grid, xb);
  do_phase<4>(p, ph_lo, ph_hi, smem, grid, xb);
  do_phase<5>(p, ph_lo, ph_hi, smem, grid, xb);
  do_phase<6>(p, ph_lo, ph_hi, smem, grid, xb);
  do_phase<7>(p, ph_lo, ph_hi, smem, grid, xb);
  do_phase<8>(p, ph_lo, ph_hi, smem, grid, xb);
  do_phase<9>(p, ph_lo, ph_hi, smem, grid, xb);
  do_phase<10>(p, ph_lo, ph_hi, smem, grid, xb);
  do_phase<11>(p, ph_lo, ph_hi, smem, grid, xb);
  do_phase<12>(p, ph_lo, ph_hi, smem, grid, xb);
  do_phase<13>(p, ph_lo, ph_hi, smem, grid, xb);
  do_phase<14>(p, ph_lo, ph_hi, smem, grid, xb);
  do_phase<15>(p, ph_lo, ph_hi, smem, grid, xb);
  do_phase<16>(p, ph_lo, ph_hi, smem, grid, xb);
  do_phase<17>(p, ph_lo, ph_hi, smem, grid, xb);
  do_phase<18>(p, ph_lo, ph_hi, smem, grid, xb);
  do_phase<19>(p, ph_lo, ph_hi, smem, grid, xb);
}

#ifndef N_LAUNCH_PER_PHASE
#define N_LAUNCH_PER_PHASE 0
#endif

extern "C" void kernel_launch(void* const* d_in, const int* in_sizes, int n_in, void* d_out, int out_size, void* d_ws, size_t ws_size, hipStream_t stream) {
  constexpr size_t kDynLds = LDS_BYTES + 16;
  static int grid_blocks = 0;
  if (!grid_blocks) {
    int dev = 0, cus = 0, per_cu = 0;
    (void)hipGetDevice(&dev);
    (void)hipDeviceGetAttribute(&cus, hipDeviceAttributeMultiprocessorCount, dev);
    (void)hipFuncSetAttribute((const void*)mega, hipFuncAttributeMaxDynamicSharedMemorySize, (int)kDynLds);
    (void)hipOccupancyMaxActiveBlocksPerMultiprocessor(&per_cu, mega, NTHR, kDynLds);
    if (per_cu > 1) per_cu = 1;
    if (per_cu < 1) per_cu = 1;
    grid_blocks = cus * per_cu;
    if (ws_size < WS_END || n_in != 41) fprintf(stderr, "kernel_launch: unexpected ws_size %zu (need %zu) or n_in %d\n", ws_size, (size_t)WS_END, n_in);
  }
  (void)hipMemsetAsync((unsigned char*)d_ws + M_BAR, 0, XCD_BAR_WORDS * sizeof(unsigned), stream);
  P p{};
  for (int i = 0; i < 41; ++i) p.in[i] = (const float*)d_in[i];
  p.out = (float*)d_out; p.ws = (unsigned char*)d_ws;
#if N_LAUNCH_PER_PHASE
  for (int ph = 0; ph < NPHASE; ++ph) hipLaunchKernelGGL(mega, dim3(grid_blocks), dim3(NTHR), kDynLds, stream, p, ph, ph + 1);
#else
  int lo = 0, hi = NPHASE;
  void* args[] = {&p, &lo, &hi};
  hipError_t e = hipLaunchCooperativeKernel((void*)mega, dim3(grid_blocks), dim3(NTHR), args, kDynLds, stream);
  if (e != hipSuccess) fprintf(stderr, "cooperative launch failed: %s (grid %d)\n", hipGetErrorString(e), grid_blocks);
#endif
}
```

```cpp
#include <hip/hip_runtime.h>
#include <hip/hip_cooperative_groups.h>
#include <cstdio>
namespace cg = cooperative_groups;

typedef __bf16 hf;
typedef __bf16 h8 __attribute__((ext_vector_type(8)));
typedef __bf16 h4 __attribute__((ext_vector_type(4)));
typedef __bf16 h2 __attribute__((ext_vector_type(2)));
typedef float f16v __attribute__((ext_vector_type(16)));
typedef float f4 __attribute__((ext_vector_type(4)));
#define MFMA16(a, b, c) __builtin_amdgcn_mfma_f32_16x16x32_bf16((a), (b), (c), 0, 0, 0)
struct Acc { f4 v[4][8]; };
typedef short s4v __attribute__((__vector_size__(4 * sizeof(short))));
typedef __attribute__((address_space(3))) s4v* lds_s4p;

#define DI __device__ __forceinline__
#define MFMA(a, b, c) __builtin_amdgcn_mfma_f32_32x32x16_bf16((a), (b), (c), 0, 0, 0)

constexpr int NP = 8192;
constexpr int NT = 40960;
constexpr int FH = 2816;
constexpr float LOG2E = 1.4426950408889634f;
constexpr float QSCALE = 0.125f * LOG2E;
constexpr float KSC = 256.f;
constexpr float NEGBIG = -1e30f;

constexpr size_t OFF_H16 = 0;
constexpr size_t OFF_R1 = 83886080;
constexpr size_t OFF_R2 = OFF_R1 + 230686720;
constexpr size_t OFF_W = OFF_R2 + 125829120;
constexpr size_t W_IN0 = OFF_W;
constexpr size_t W_OUT0 = W_IN0 + 5767168;
constexpr size_t W_130 = W_OUT0 + 2097152;
constexpr size_t W_20 = W_130 + 11534336;
constexpr size_t W_IN1 = W_20 + 5767168;
constexpr size_t W_OUT1 = W_IN1 + 4194304;
constexpr size_t W_131 = W_OUT1 + 2097152;
constexpr size_t W_21 = W_131 + 11534336;
constexpr size_t W_GLU = W_21 + 5767168;
constexpr size_t OFF_MISC = W_GLU + 524288;
constexpr size_t M_MOD = OFF_MISC;
constexpr size_t M_CKA = M_MOD + 442368;
constexpr size_t M_CVA = M_CKA + 524288;
constexpr size_t M_CKD = M_CVA + 524288;
constexpr size_t M_CVD = M_CKD + 2097152;
constexpr size_t M_ROPE = M_CVD + 2097152;
constexpr size_t M_SCAL = M_ROPE + 8192;
constexpr size_t M_BAR = M_SCAL + 256;
constexpr size_t WS_END = M_BAR + 16384;
constexpr size_t R1_QA = OFF_R1, R1_KA = R1_QA + 41943040, R1_VA = R1_KA + 10485760, R1_QB = R1_VA + 10485760,
                 R1_KB = R1_QB + 41943040, R1_VB = R1_KB + 41943040, R1_GB = R1_VB + 41943040;
constexpr size_t R1_UG = OFF_R1, R1_QD = R1_UG + 41943040, R1_KD = R1_QD + 41943040, R1_VD = R1_KD + 41943040, R1_G16 = R1_VD + 41943040;
constexpr size_t R1_T16 = OFF_R1;
constexpr size_t R2_KVC = OFF_R2, R2_STT = R2_KVC + 83886080;
constexpr size_t R2_KC = OFF_R2, R2_FC = R2_KC + 2097152, R2_E = R2_FC + 16777216, R2_SC = R2_E + 16777216, R2_H = R2_SC + 20971520;
constexpr size_t O_Y = 0, O_KA = 41943040, O_VA = O_KA + 1048576, O_RET = O_VA + 1048576, O_SRE = O_RET + 2097152,
                 O_SIM = O_SRE + 131072, O_KD = O_SIM + 131072, O_VD = O_KD + 4194304;

constexpr int HALF_LDS = 67584;
constexpr int LDS_BYTES = 2 * HALF_LDS;
constexpr int NTHR = 512;

struct P { const float* in[41]; float* out; unsigned char* ws; };
typedef const __attribute__((address_space(4))) P* PP;

DI int opaque_tid() { int t = threadIdx.x; asm volatile("" : "+v"(t)); return t; }
DI int opaque_s(int x) { asm volatile("" : "+s"(x)); return x; }
DI PP opaque_p(PP p) { unsigned long long u = (unsigned long long)p; asm volatile("" : "+s"(u)); return (PP)u; }
DI int crow(int i, int hh) { return (i & 3) + 8 * (i >> 2) + 4 * hh; }
DI h4 trread(const hf* p) { s4v r = __builtin_amdgcn_ds_read_tr16_b64_v4i16((lds_s4p)(p)); return __builtin_bit_cast(h4, r); }
DI h8 cat8(h4 a, h4 b) { return __builtin_shufflevector(a, b, 0, 1, 2, 3, 4, 5, 6, 7); }
DI float ex2(float x) { return __builtin_amdgcn_exp2f(x); }
DI float sigmoidf_(float x) { return __builtin_amdgcn_rcpf(1.f + ex2(-LOG2E * x)); }
DI float siluf_(float x) { return x * __builtin_amdgcn_rcpf(1.f + ex2(-LOG2E * x)); }
DI float gelu_tanh(float x) { float u = 0.7978845608028654f * (x + 0.044715f * x * x * x); float e = ex2(-2.f * LOG2E * fabsf(u)); float t = (1.f - e) * __builtin_amdgcn_rcpf(1.f + e); t = u < 0.f ? -t : t; return 0.5f * x * (1.f + t); }
DI h2 pk(float a, float b) { h2 r; r[0] = (hf)a; r[1] = (hf)b; return r; }
DI h8 pack8(const f16v& x, int s) {
  h2 a = pk(x[8 * s + 0], x[8 * s + 1]), b = pk(x[8 * s + 2], x[8 * s + 3]), c = pk(x[8 * s + 4], x[8 * s + 5]), d = pk(x[8 * s + 6], x[8 * s + 7]);
  h8 r; r[0] = a[0]; r[1] = a[1]; r[2] = b[0]; r[3] = b[1]; r[4] = c[0]; r[5] = c[1]; r[6] = d[0]; r[7] = d[1]; return r;
}
DI f16v zero16() { f16v z; for (int i = 0; i < 16; ++i) z[i] = 0.f; return z; }
DI void cpowd(double lr, double li, double dt, int n, double& re, double& im) {
  const double mag = exp(lr * dt * (double)n);
  const double rev = li * dt * (double)n * 0.15915494309189535;
  const double th = (rev - floor(rev)) * 6.283185307179586;
  re = mag * cos(th); im = mag * sin(th);
}

DI size_t tix(int row, int k, int nrows) { return ((size_t)(k >> 5) * (size_t)nrows + (size_t)row) * 32 + (size_t)(k & 31); }
struct LdTiled { const hf* base; int nrows; int row0; DI const hf* operator()(int r, int k) const { return base + tix(row0 + r, k, nrows); } };
struct LdToep { const hf* kc; int row0; DI const hf* operator()(int r, int k) const { int n = row0 + r; int t = n >> 4, co = n & 15, s = k >> 4, ci = k & 15; return kc + ((t - s + 63) * 16 + co) * 16 + ci; } };

#define RAW_BARRIER() do { asm volatile("s_waitcnt lgkmcnt(0)" ::: "memory"); __builtin_amdgcn_s_barrier(); } while (0)
typedef __attribute__((address_space(3))) unsigned* lds_u32p;
typedef __attribute__((address_space(1))) const unsigned* glb_u32p;

constexpr int STG = (256 + 256) * 32;
DI int swz4(int x) { return (0x78 >> (2 * x)) & 3; }
template <class LA, class LB>
DI void gemm_piece(const LA& la, const LB& lb, int kt, int buf, int piece, hf* sm, int tid) {
  const int w = tid >> 6, l = tid & 63;
  const int rl = l >> 2, cch = ((l & 3) ^ swz4((l >> 4) & 3)) * 8;
  hf* st = sm + buf * STG;
  const int k = kt * 32 + cch;
  const int blk = w * 2 + (piece & 1);
  if (piece < 2) __builtin_amdgcn_global_load_lds((glb_u32p)la(blk * 16 + rl, k), (lds_u32p)(st + blk * 512), 16, 0, 0);
  else __builtin_amdgcn_global_load_lds((glb_u32p)lb(blk * 16 + rl, k), (lds_u32p)(st + 256 * 32 + blk * 512), 16, 0, 0);
}
template <class LA, class LB>
DI void gemm_issue(const LA& la, const LB& lb, int kt, int buf, hf* sm, int tid) {
#pragma unroll
  for (int pc = 0; pc < 4; ++pc) gemm_piece(la, lb, kt, buf, pc, sm, tid);
}
template <class LA, class LB>
DI void gemm_prologue(const LA& la, const LB& lb, int nk, hf* sm, int tid) {
  gemm_issue(la, lb, 0, 0, sm, tid);
  if (nk > 1) gemm_issue(la, lb, 1, 1, sm, tid);
}
template <bool PF, class LA, class LB>
DI void gemm_stage(Acc& acc, const LA& la, const LB& lb, int kt, int buf, hf* sm, int tid) {
  const int w = tid >> 6, l = tid & 63, wm = w >> 1, wn = w & 1, r16 = l & 15, c4 = l >> 4;
  const int slot = (c4 ^ swz4((r16 >> 2) & 3)) * 8;
  const int nb = buf >= 1 ? buf - 1 : 2;
  const hf* sa = sm + buf * STG + (wm * 64 + r16) * 32 + slot;
  const hf* sb = sm + buf * STG + 256 * 32 + (wn * 128 + r16) * 32 + slot;
  h8 af[4], bf[8];
#pragma unroll
  for (int m = 0; m < 4; ++m) af[m] = *(const h8*)(sa + m * 16 * 32);
#pragma unroll
  for (int n = 0; n < 8; ++n) bf[n] = *(const h8*)(sb + n * 16 * 32);
#pragma unroll
  for (int g = 0; g < 2; ++g)
#pragma unroll
    for (int m = 0; m < 4; ++m) { acc.v[m][2 * g] = MFMA16(af[m], bf[2 * g], acc.v[m][2 * g]); acc.v[m][2 * g + 1] = MFMA16(af[m], bf[2 * g + 1], acc.v[m][2 * g + 1]); }
  __builtin_amdgcn_sched_barrier(0);
#pragma unroll
  for (int g = 2; g < 4; ++g) {
#pragma unroll
    for (int m = 0; m < 4; ++m) { acc.v[m][2 * g] = MFMA16(af[m], bf[2 * g], acc.v[m][2 * g]); acc.v[m][2 * g + 1] = MFMA16(af[m], bf[2 * g + 1], acc.v[m][2 * g + 1]); }
    if (PF) { gemm_piece(la, lb, kt + 2, nb, 2 * (g - 2), sm, tid); gemm_piece(la, lb, kt + 2, nb, 2 * (g - 2) + 1, sm, tid); }
  }
  __builtin_amdgcn_sched_barrier(0);
}
template <class LA, class LB>
DI void gemm_loop(Acc& acc, const LA& la, const LB& lb, int nk, hf* sm, int tid) {
  int buf = 0;
  for (int kt = 0; kt < nk - 2; ++kt) {
    if (kt > 0) asm volatile("s_waitcnt vmcnt(4)" ::: "memory"); else asm volatile("s_waitcnt vmcnt(0)" ::: "memory");
    RAW_BARRIER();
    gemm_stage<true>(acc, la, lb, kt, buf, sm, tid);
    buf = buf == 2 ? 0 : buf + 1;
  }
  for (int kt = (nk >= 2 ? nk - 2 : 0); kt < nk; ++kt) {
    if (kt > 0 && kt + 1 < nk) asm volatile("s_waitcnt vmcnt(4)" ::: "memory"); else asm volatile("s_waitcnt vmcnt(0)" ::: "memory");
    RAW_BARRIER();
    gemm_stage<false>(acc, la, lb, kt, buf, sm, tid);
    buf = buf == 2 ? 0 : buf + 1;
  }
  RAW_BARRIER();
}
template <class LA, class LB>
DI void gemm_main(Acc& acc, const LA& la, const LB& lb, int nk, hf* sm, int tid) {
  gemm_prologue(la, lb, nk, sm, tid);
  gemm_loop(acc, la, lb, nk, sm, tid);
  __syncthreads();
}
DI void zero_acc(Acc& acc) {
#pragma unroll
  for (int m = 0; m < 4; ++m)
#pragma unroll
    for (int n = 0; n < 8; ++n) { acc.v[m][n][0] = 0.f; acc.v[m][n][1] = 0.f; acc.v[m][n][2] = 0.f; acc.v[m][n][3] = 0.f; }
}
DI void acc_to_lds(const Acc& acc, float* ct0, int tid, int pass) {
  const int w = tid >> 6, l = tid & 63, wm = w >> 1, wn = w & 1, r16 = l & 15, c4 = l >> 4;
  if (wn == pass) {
    float* ct = ct0 + (wm >> 1) * (HALF_LDS / 4);
#pragma unroll
    for (int m = 0; m < 4; ++m)
#pragma unroll
      for (int n = 0; n < 8; ++n)
#pragma unroll
        for (int i = 0; i < 4; ++i) ct[((wm & 1) * 64 + m * 16 + 4 * c4 + i) * 132 + n * 16 + r16] = acc.v[m][n][i];
  }
}
DI void tile_map(int t, int G, int total, int ntn, int& mt, int& nt) {
  const int q = t / G, b = t - q * G;
  const int rem = total - q * G;
  const int per = (rem >= G ? G : rem) >> 3;
  const int L = q * G + (b & 7) * per + (b >> 3);
  const int grp = 8 * ntn;
  const int mb = L / grp, r = L - mb * grp;
  nt = r >> 3; mt = mb * 8 + (r & 7);
}
DI void ld16(const float* ct, int r, int c16, float (&v)[16]) {
#pragma unroll
  for (int j = 0; j < 4; ++j) { f4 t = *(const f4*)(ct + r * 132 + c16 * 16 + 4 * j); v[4 * j] = t[0]; v[4 * j + 1] = t[1]; v[4 * j + 2] = t[2]; v[4 * j + 3] = t[3]; }
}
DI void st16h(hf* dst, const float (&v)[16]) {
  h8 a, b;
#pragma unroll
  for (int j = 0; j < 8; ++j) { a[j] = (hf)v[j]; b[j] = (hf)v[8 + j]; }
  *(h8*)dst = a; *(h8*)(dst + 8) = b;
}
DI void st16f(float* dst, const float (&v)[16]) {
#pragma unroll
  for (int j = 0; j < 4; ++j) { f4 t; t[0] = v[4 * j]; t[1] = v[4 * j + 1]; t[2] = v[4 * j + 2]; t[3] = v[4 * j + 3]; *(f4*)(dst + 4 * j) = t; }
}
DI float quad_xor1(float x) { return __builtin_bit_cast(float, __builtin_amdgcn_mov_dpp(__builtin_bit_cast(int, x), 0xB1, 0xF, 0xF, true)); }
DI float quad_xor2(float x) { return __builtin_bit_cast(float, __builtin_amdgcn_mov_dpp(__builtin_bit_cast(int, x), 0x4E, 0xF, 0xF, true)); }
DI void rope16(float (&v)[16], int q, int tpos, const float* rope) {
  const int pos = (q & 1) ? (tpos & 63) : (tpos >> 6);
  const float* rp = rope + pos * 32;
#pragma unroll
  for (int j = 0; j < 16; ++j) {
    float pv = quad_xor2(v[j]);
    float c = rp[2 * j], s = rp[2 * j + 1];
    v[j] = (q < 2) ? (v[j] * c - pv * s) : (v[j] * c + pv * s);
  }
}
DI void norm16(float (&v)[16], const float* gam, int q) {
  float ss = 0.f;
#pragma unroll
  for (int j = 0; j < 16; ++j) ss += v[j] * v[j];
  ss += quad_xor1(ss); ss += quad_xor2(ss);
  const float rstd = rsqrtf(ss * (1.f / 64.f) + 1e-6f);
#pragma unroll
  for (int j = 0; j < 16; ++j) v[j] = v[j] * rstd * gam[q * 16 + j];
}

struct KVSeg { const hf* K; const hf* V; int kld, vld, ntiles, kpos0; };

template <int DV>
DI void attn_run(f16v (&O)[DV / 32], const hf* Q, int qld, const KVSeg& s0, const KVSeg& s1, float m_init, float l_init, int qpos0, bool band, hf* sm, int tid) {
  constexpr int VS = DV + 32;
  constexpr int NV = DV / 32;
  hf* sK = sm; hf* sV = sm + 2 * 64 * 72;
  const int w = tid >> 6, l = tid & 63, lr32 = l & 31, hh = l >> 5;
  h8 qf[4];
  {
    const hf* qp = Q + (size_t)(w * 32 + lr32) * qld + 8 * hh;
#pragma unroll
    for (int ks = 0; ks < 4; ++ks) qf[ks] = *(const h8*)(qp + ks * 16);
  }
  float m = m_init, ls = hh == 0 ? l_init : 0.f;
#pragma unroll
  for (int d = 0; d < NV; ++d) O[d] = zero16();
  const int n0 = s0.ntiles, ntot = s0.ntiles + s1.ntiles;
  const int kr = tid >> 3, kc = (tid & 7) * 8;
  const int vr = (DV == 64) ? (tid >> 3) : (tid >> 4), vc = (DV == 64) ? (tid & 7) * 8 : (tid & 15) * 8;
  constexpr int VRS = (DV == 64) ? 32 : 16;
  h8 rk[2], rv[NV];
  auto gload = [&](int i) {
    const hf* kp; const hf* vp; int kld, vld;
    if (i < n0) { kp = s0.K + (size_t)(i * 64) * s0.kld; vp = s0.V + (size_t)(i * 64) * s0.vld; kld = s0.kld; vld = s0.vld; }
    else { kp = s1.K + (size_t)((i - n0) * 64) * s1.kld; vp = s1.V + (size_t)((i - n0) * 64) * s1.vld; kld = s1.kld; vld = s1.vld; }
#pragma unroll
    for (int j = 0; j < 2; ++j) rk[j] = *(const h8*)(kp + (size_t)(kr + 32 * j) * kld + kc);
#pragma unroll
    for (int j = 0; j < NV; ++j) rv[j] = *(const h8*)(vp + (size_t)(vr + VRS * j) * vld + vc);
  };
  auto sstore = [&](int buf) {
#pragma unroll
    for (int j = 0; j < 2; ++j) *(h8*)(sK + buf * 64 * 72 + (kr + 32 * j) * 72 + kc) = rk[j];
#pragma unroll
    for (int j = 0; j < NV; ++j) *(h8*)(sV + buf * 64 * VS + (vr + VRS * j) * VS + vc) = rv[j];
  };
  gload(0); sstore(0);
  __syncthreads();
  const int i16 = l & 15, q4 = i16 >> 2, p4 = i16 & 3, blk = (l >> 4) & 1;
  const int voff = (4 * hh + q4) * VS + 16 * blk + 4 * p4;
  const int qmin = qpos0 + w * 32, qpos = qmin + lr32;
  for (int i = 0; i < ntot; ++i) {
    const int cur = i & 1;
    if (i + 1 < ntot) gload(i + 1);
    const bool masked = band && i >= n0;
    const int kbase = s1.kpos0 + (i - n0) * 64;
    const bool skip = masked && (kbase > qmin + 31 + 128 || kbase + 63 < qmin - 128);
    if (!skip) {
      f16v st[2];
#pragma unroll
      for (int kb = 0; kb < 2; ++kb) {
        st[kb] = zero16();
        const hf* kp = sK + cur * 64 * 72 + (kb * 32 + lr32) * 72 + 8 * hh;
#pragma unroll
        for (int ks = 0; ks < 4; ++ks) { h8 kf = *(const h8*)(kp + ks * 16); st[kb] = MFMA(kf, qf[ks], st[kb]); }
      }
      if (masked) {
#pragma unroll
        for (int kb = 0; kb < 2; ++kb)
#pragma unroll
          for (int e = 0; e < 16; ++e) { int kpos = kbase + kb * 32 + crow(e, hh); int dd = qpos - kpos; if (dd > 128 || dd < -128) st[kb][e] = NEGBIG; }
      }
      float mx = st[0][0];
#pragma unroll
      for (int kb = 0; kb < 2; ++kb)
#pragma unroll
        for (int e = 0; e < 16; ++e) mx = fmaxf(mx, st[kb][e]);
      mx = fmaxf(mx, __shfl_xor(mx, 32));
      const float mnew = fmaxf(m, mx);
      const float alpha = ex2(m - mnew);
      m = mnew;
      float psum = 0.f;
#pragma unroll
      for (int kb = 0; kb < 2; ++kb)
#pragma unroll
        for (int e = 0; e < 16; ++e) { float pe = ex2(st[kb][e] - mnew); st[kb][e] = pe; psum += pe; }
      ls = ls * alpha + psum;
      if (__builtin_amdgcn_ballot_w64(alpha != 1.f) != 0ull) {
#pragma unroll
        for (int d = 0; d < NV; ++d)
#pragma unroll
          for (int e = 0; e < 16; ++e) O[d][e] *= alpha;
      }
      const hf* vb = sV + cur * 64 * VS + voff;
#pragma unroll
      for (int kb = 0; kb < 2; ++kb)
#pragma unroll
        for (int s = 0; s < 2; ++s) {
          const h8 pf = pack8(st[kb], s);
          const hf* vp = vb + (kb * 32 + 16 * s) * VS;
#pragma unroll
          for (int d = 0; d < NV; ++d) {
            h8 vf = cat8(trread(vp + d * 32), trread(vp + 8 * VS + d * 32));
            O[d] = MFMA(vf, pf, O[d]);
          }
        }
    }
    if (i + 1 < ntot) sstore(cur ^ 1);
    __syncthreads();
  }
  const float lt = ls + __shfl_xor(ls, 32);
  const float inv = 1.f / lt;
#pragma unroll
  for (int d = 0; d < NV; ++d)
#pragma unroll
    for (int e = 0; e < 16; ++e) O[d][e] *= inv;
}

DI void transpose_tile(const float* src, int N, hf* dst, int nrows, int kt, int nt, int drow0, float* tile, int tid) {
#pragma unroll
  for (int i = 0; i < 4; ++i) {
    int k = (tid >> 4) + 16 * i, n4 = (tid & 15) * 4;
    f4 v = *(const f4*)(src + (size_t)(kt * 64 + k) * N + nt * 64 + n4);
    tile[k * 65 + n4] = v[0]; tile[k * 65 + n4 + 1] = v[1]; tile[k * 65 + n4 + 2] = v[2]; tile[k * 65 + n4 + 3] = v[3];
  }
  __syncthreads();
  {
    int n = tid >> 2, kc = (tid & 3) * 16;
    h8 a, b;
#pragma unroll
    for (int j = 0; j < 8; ++j) { a[j] = (hf)tile[(kc + j) * 65 + n]; b[j] = (hf)tile[(kc + 8 + j) * 65 + n]; }
    hf* d = dst + tix(drow0 + n, kt * 64 + kc, nrows);
    *(h8*)d = a; *(h8*)(d + 8) = b;
  }
  __syncthreads();
}

DI void phase_prep(PP p, unsigned char* smem) {
  const int tf = opaque_tid(); const int half = tf >> 8; const int tid = tf & 255;
  float* smf = (float*)(smem + half * HALF_LDS);
  constexpr int NTR = 6016, NADA = 384, NCV = 1280;
  for (int pit = opaque_s(blockIdx.x); pit < (NTR + NADA + NCV) / 2 + 1; pit += gridDim.x) {
    const int it = pit < (NTR + NADA + NCV) / 2 ? 2 * pit + half : NTR + NADA + NCV + half;
    if (it < NTR) {
      int t = it; const float* src; hf* dst; int K, N, ldk, inter = 0;
      if (t < 704) { src = p->in[18]; dst = (hf*)(p->ws + W_IN0); K = 1024; N = 2816; }
      else if ((t -= 704) < 256) { src = p->in[19]; dst = (hf*)(p->ws + W_OUT0); K = 1024; N = 1024; }
      else if ((t -= 256) < 704) { src = p->in[15]; dst = (hf*)(p->ws + W_130); K = 1024; N = 2816; inter = 1; }
      else if ((t -= 704) < 704) { src = p->in[16]; dst = (hf*)(p->ws + W_130); K = 1024; N = 2816; inter = 2; }
      else if ((t -= 704) < 704) { src = p->in[17]; dst = (hf*)(p->ws + W_20); K = 2816; N = 1024; }
      else if ((t -= 704) < 512) { src = p->in[25]; dst = (hf*)(p->ws + W_IN1); K = 1024; N = 2048; }
      else if ((t -= 512) < 256) { src = p->in[26]; dst = (hf*)(p->ws + W_OUT1); K = 1024; N = 1024; }
      else if ((t -= 256) < 704) { src = p->in[15] + (size_t)1024 * 2816; dst = (hf*)(p->ws + W_131); K = 1024; N = 2816; inter = 1; }
      else if ((t -= 704) < 704) { src = p->in[16] + (size_t)1024 * 2816; dst = (hf*)(p->ws + W_131); K = 1024; N = 2816; inter = 2; }
      else if ((t -= 704) < 704) { src = p->in[17] + (size_t)2816 * 1024; dst = (hf*)(p->ws + W_21); K = 2816; N = 1024; }
      else { t -= 704; src = p->in[35]; dst = (hf*)(p->ws + W_GLU); K = 512; N = 512; }
      ldk = inter ? 2 * N : N; (void)K;
      const int ntn = N / 64; const int kt = t / ntn, nt = t % ntn;
      const int drow0 = inter == 0 ? nt * 64 : (nt * 128 + (inter == 2 ? 64 : 0));
      transpose_tile(src, N, dst, ldk, kt, nt, drow0, smf, tid);
    } else if (it < NTR + NADA) {
      const int t = it - NTR; const int layer = t / 192, n0 = (t % 192) * 32;
      float* sc = smf;
      float* red = smf + 9 * 1024;
      for (int e = tid; e < 9 * 1024; e += 256) { int ci = e >> 10, k = e & 1023; float c = ci < 8 ? p->in[2][ci * 1024 + k] : p->in[3][k]; sc[e] = siluf_(c); }
      __syncthreads();
      const int col = tid & 31, kg = tid >> 5;
      const float* wp = p->in[11] + (size_t)layer * 1024 * 6144 + n0 + col;
      float a[9];
#pragma unroll
      for (int c = 0; c < 9; ++c) a[c] = 0.f;
#pragma unroll 8
      for (int k = kg * 128; k < kg * 128 + 128; ++k) {
        float wv = wp[(size_t)k * 6144];
#pragma unroll
        for (int c = 0; c < 9; ++c) a[c] += sc[c * 1024 + k] * wv;
      }
#pragma unroll
      for (int c = 0; c < 9; ++c) red[(kg * 9 + c) * 32 + col] = a[c];
      __syncthreads();
      float* mod = (float*)(p->ws + M_MOD);
      for (int e = tid; e < 9 * 32; e += 256) {
        int c = e >> 5, cl = e & 31;
        float sum = 0.f;
#pragma unroll
        for (int q = 0; q < 8; ++q) sum += red[(q * 9 + c) * 32 + cl];
        mod[((size_t)layer * 9 + c) * 6144 + n0 + cl] = sum + p->in[12][layer * 6144 + n0 + cl];
      }
      __syncthreads();
    } else if (it < NTR + NADA + NCV) {
      int t = it - NTR - NADA;
      if (t < 128) {
        int e = (t * 256 + tid) * 8; int d = e & 63, key = (e >> 6) & 255, g = (e >> 14) & 1, b = e >> 15;
        const float* s = p->in[4] + ((size_t)(b * 256 + key) * 2 + g) * 64 + d;
        h8 o;
#pragma unroll
        for (int j = 0; j < 8; ++j) o[j] = (hf)s[j];
        *(h8*)((hf*)(p->ws + M_CKA) + e) = o;
      } else if ((t -= 128) < 128) {
        int e = (t * 256 + tid) * 8; int d = e & 63, key = (e >> 6) & 255, g = (e >> 14) & 1, b = e >> 15;
        const float* s = p->in[5] + ((size_t)(b * 256 + key) * 2 + g) * 64 + d;
        h8 o;
#pragma unroll
        for (int j = 0; j < 8; ++j) o[j] = (hf)s[j];
        *(h8*)((hf*)(p->ws + M_CVA) + e) = o;
      } else if ((t -= 128) < 512) {
        int e = (t * 256 + tid) * 8; int d = e & 63, key = (e >> 6) & 255, c = (e >> 14) & 1, h = (e >> 15) & 3, b = e >> 17;
        const float* s = p->in[9] + (((size_t)(b * 256 + key) * 4 + h) * 2 + c) * 64 + d;
        h8 o;
#pragma unroll
        for (int j = 0; j < 8; ++j) o[j] = (hf)s[j];
        *(h8*)((hf*)(p->ws + M_CKD) + e) = o;
      } else {
        t -= 512;
        int e = (t * 256 + tid) * 8; int d = e & 127, key = (e >> 7) & 255, h = (e >> 15) & 3, b = e >> 17;
        const float* s = p->in[10] + ((size_t)(b * 256 + key) * 4 + h) * 128 + d;
        h8 o;
#pragma unroll
        for (int j = 0; j < 8; ++j) o[j] = (hf)s[j];
        *(h8*)((hf*)(p->ws + M_CVD) + e) = o;
      }
    } else if (it == NTR + NADA + NCV) {
      float* rope = (float*)(p->ws + M_ROPE);
      for (int e = tid; e < 1024; e += 256) {
        int pos = e >> 4, f = e & 15;
        float inv = (float)exp2(-(double)f * (13.287712379549449 / 16.0));
        const double ang = (double)((float)pos * inv);
        rope[2 * e] = (float)cos(ang); rope[2 * e + 1] = (float)sin(ang);
      }
      float* scal = (float*)(p->ws + M_SCAL);
      if (tid == 0) {
        const float* lp = p->in[39];
        float s01 = 0.f, s23 = 0.f;
        for (int j = 0; j < 64; ++j) { s01 += lp[j] * lp[64 + j]; s23 += lp[128 + j] * lp[192 + j]; }
        scal[0] = __expf(s01) - __expf(s23) + 0.35550906759096994f;
      }
      if (tid >= 16 && tid < 32) { float x = p->in[23][tid - 16]; float e = __expf(-x); scal[tid] = -(e - 0.5f * e * e + 0.33333333f * e * e * e); }
    }
  }
}

DI void phase_norm(PP p, int layer, int which) {
  const float* gam = p->in[which ? 14 : 13] + layer * 1024;
  const float* mod = (const float*)(p->ws + M_MOD) + (size_t)layer * 9 * 6144;
  hf* h16 = (hf*)(p->ws + OFF_H16);
  const int tid = opaque_tid(); const int wave = tid >> 6, lane = tid & 63;
  const bool from_in = (layer == 0 && which == 0);
  const int G = gridDim.x;
  const int rpw = (((NT + G - 1) / G + 15) / 16) * 2;
  const int r0 = (opaque_s(blockIdx.x) * 8 + wave) * rpw;
  int cur = -1;
  float gm[16], shv[16];
#pragma unroll 1
  for (int row = r0; row < r0 + rpw && row < NT; row += 2) {
    const int cond = row < NP ? 8 : (row - NP) >> 12;
    if (cond != cur) {
      cur = cond;
      const float* sh = mod + cond * 6144 + (which ? 3 * 1024 : 0);
#pragma unroll
      for (int i = 0; i < 4; ++i) {
        const int k = lane * 4 + 256 * i;
        f4 g = *(const f4*)(gam + k), s1 = *(const f4*)(sh + 1024 + k), s0 = *(const f4*)(sh + k);
#pragma unroll
        for (int j = 0; j < 4; ++j) { gm[4 * i + j] = g[j] * (1.f + s1[j]); shv[4 * i + j] = s0[j]; }
      }
    }
    const float* x = from_in ? (row < NP ? p->in[0] + (size_t)row * 1024 : p->in[1] + (size_t)(row - NP) * 1024) : p->out + O_Y + (size_t)row * 1024;
    f4 va[4], vb[4]; float sa = 0.f, sb = 0.f;
#pragma unroll
    for (int i = 0; i < 4; ++i) { va[i] = *(const f4*)(x + lane * 4 + 256 * i); vb[i] = *(const f4*)(x + 1024 + lane * 4 + 256 * i); }
#pragma unroll
    for (int i = 0; i < 4; ++i) {
      sa += va[i][0] * va[i][0] + va[i][1] * va[i][1] + va[i][2] * va[i][2] + va[i][3] * va[i][3];
      sb += vb[i][0] * vb[i][0] + vb[i][1] * vb[i][1] + vb[i][2] * vb[i][2] + vb[i][3] * vb[i][3];
    }
#pragma unroll
    for (int o = 32; o >= 1; o >>= 1) { sa += __shfl_xor(sa, o); sb += __shfl_xor(sb, o); }
    const float ra = rsqrtf(sa * (1.f / 1024.f) + 1e-6f), rb = rsqrtf(sb * (1.f / 1024.f) + 1e-6f);
#pragma unroll
    for (int i = 0; i < 4; ++i) {
      const int k = lane * 4 + 256 * i;
      h4 oa, ob;
#pragma unroll
      for (int j = 0; j < 4; ++j) { oa[j] = (hf)(va[i][j] * ra * gm[4 * i + j] + shv[4 * i + j]); ob[j] = (hf)(vb[i][j] * rb * gm[4 * i + j] + shv[4 * i + j]); }
      *(h4*)(h16 + tix(row, k, NT)) = oa;
      *(h4*)(h16 + tix(row + 1, k, NT)) = ob;
    }
  }
}

DI void epi_ab(PP p, const float* ct, int row0, int nt, int tid) {
  const int c8 = tid & 7, q = c8 & 3;
  const float* rope = (const float*)(p->ws + M_ROPE);
  const bool latent = row0 >= NP;
#pragma unroll 1
  for (int ps = 0; ps < 4; ++ps) {
    const int r = ps * 32 + (tid >> 3); const int row = row0 + r;
    float v[16]; ld16(ct, r, c8, v);
    const int tpos = (row - NP) & 4095;
    if (nt < 4) {
      norm16(v, p->in[20], q);
      if (latent) rope16(v, q, tpos, rope);
#pragma unroll
      for (int j = 0; j < 16; ++j) v[j] *= QSCALE;
      st16h((hf*)(p->ws + R1_QA) + (size_t)row * 512 + nt * 128 + c8 * 16, v);
    } else if (nt == 4) {
      norm16(v, p->in[21], q);
      if (!latent) st16f(p->out + O_KA + (size_t)row * 128 + c8 * 16, v);
      else rope16(v, q, tpos, rope);
      st16h((hf*)(p->ws + R1_KA) + (size_t)row * 128 + c8 * 16, v);
    } else if (nt == 5) {
      if (!latent) st16f(p->out + O_VA + (size_t)row * 128 + c8 * 16, v);
      st16h((hf*)(p->ws + R1_VA) + (size_t)row * 128 + c8 * 16, v);
    } else {
      const int sel = (nt - 6) >> 2, sub = (nt - 6) & 3;
      if (sel == 0) {
#pragma unroll
        for (int j = 0; j < 16; ++j) v[j] *= 0.125f;
      }
      const size_t base = sel == 0 ? R1_QB : sel == 1 ? R1_KB : sel == 2 ? R1_VB : R1_GB;
      st16h((hf*)(p->ws + base) + (size_t)row * 512 + sub * 128 + c8 * 16, v);
    }
  }
}
DI void epi_cd(PP p, const float* ct, int row0, int nt, int tid) {
  const int c8 = tid & 7, q = c8 & 3;
  const float* rope = (const float*)(p->ws + M_ROPE);
  const bool latent = row0 >= NP;
#pragma unroll 1
  for (int ps = 0; ps < 4; ++ps) {
    const int r = ps * 32 + (tid >> 3); const int row = row0 + r;
    float v[16]; ld16(ct, r, c8, v);
    const int tpos = (row - NP) & 4095;
    if (nt < 4) {
      st16h((hf*)(p->ws + R1_UG) + (size_t)(nt * 8 + c8) * (NT * 16) + tix(row >> 6, (row & 63) * 16, 640), v);
    } else if (nt < 8) {
      norm16(v, p->in[37], q);
      if (latent) rope16(v, q, tpos, rope);
#pragma unroll
      for (int j = 0; j < 16; ++j) v[j] *= QSCALE;
      st16h((hf*)(p->ws + R1_QD) + (size_t)row * 512 + (nt - 4) * 128 + c8 * 16, v);
    } else if (nt < 12) {
      norm16(v, p->in[38], q);
      if (!latent) st16f(p->out + O_KD + (size_t)row * 512 + (nt - 8) * 128 + c8 * 16, v);
      else rope16(v, q, tpos, rope);
      st16h((hf*)(p->ws + R1_KD) + (size_t)row * 512 + (nt - 8) * 128 + c8 * 16, v);
    } else {
      if (!latent) st16f(p->out + O_VD + (size_t)row * 512 + (nt - 12) * 128 + c8 * 16, v);
      st16h((hf*)(p->ws + R1_VD) + (size_t)row * 512 + (nt - 12) * 128 + c8 * 16, v);
    }
  }
}
DI void epi_res(PP p, const float* ct, int row0, int nt, int tid, int layer, int gi, bool from_in) {
  const int c8 = tid & 7;
  const float* mod = (const float*)(p->ws + M_MOD) + (size_t)layer * 9 * 6144;
  const int cond = row0 < NP ? 8 : (row0 - NP) >> 12;
  const float* gate = mod + cond * 6144 + gi * 1024 + nt * 128 + c8 * 16;
  float gv[16];
#pragma unroll
  for (int j = 0; j < 16; ++j) gv[j] = gate[j];
#pragma unroll 1
  for (int ps = 0; ps < 4; ++ps) {
    const int r = ps * 32 + (tid >> 3); const int row = row0 + r;
    float v[16]; ld16(ct, r, c8, v);
    const float* xin = from_in ? (row < NP ? p->in[0] + (size_t)row * 1024 : p->in[1] + (size_t)(row - NP) * 1024) : p->out + O_Y + (size_t)row * 1024;
    xin += nt * 128 + c8 * 16;
#pragma unroll
    for (int j = 0; j < 4; ++j) { f4 xv = *(const f4*)(xin + 4 * j); v[4 * j] = xv[0] + gv[4 * j] * v[4 * j]; v[4 * j + 1] = xv[1] + gv[4 * j + 1] * v[4 * j + 1]; v[4 * j + 2] = xv[2] + gv[4 * j + 2] * v[4 * j + 2]; v[4 * j + 3] = xv[3] + gv[4 * j + 3] * v[4 * j + 3]; }
    st16f(p->out + O_Y + (size_t)row * 1024 + nt * 128 + c8 * 16, v);
  }
}
DI void epi_ffn13(PP p, const float* ct, int row0, int nt, int tid) {
  const int j0 = (tid & 7) * 8;
  hf* t16 = (hf*)(p->ws + R1_T16);
#pragma unroll 1
  for (int ps = 0; ps < 4; ++ps) {
    const int r = ps * 32 + (tid >> 3);
    f4 a0 = *(const f4*)(ct + r * 132 + j0), a1 = *(const f4*)(ct + r * 132 + j0 + 4);
    f4 b0 = *(const f4*)(ct + r * 132 + 64 + j0), b1 = *(const f4*)(ct + r * 132 + 64 + j0 + 4);
    h8 o;
#pragma unroll
    for (int j = 0; j < 4; ++j) { o[j] = (hf)(siluf_(a0[j]) * b0[j]); o[4 + j] = (hf)(siluf_(a1[j]) * b1[j]); }
    *(h8*)(t16 + tix(row0 + r, nt * 64 + j0, NT)) = o;
  }
}

DI int gemm_ntn(int kind) { return kind == 0 ? 11 : kind == 1 ? 8 : kind == 2 ? 4 : kind == 3 ? 22 : kind == 4 ? 4 : 2; }
DI void gemm_tile_std(PP p, int kind, int layer, int t, unsigned char* smem) {
  const int tf = opaque_tid();
  const int hb = tf >> 8, tid = tf & 255;
  hf* sm = (hf*)smem; float* ct0 = (float*)smem; const float* ct = ct0 + hb * (HALF_LDS / 4);
  const hf* A; const hf* B; int K; size_t lda;
  switch (kind) {
    case 0: A = (const hf*)(p->ws + OFF_H16); lda = 1024; B = (const hf*)(p->ws + W_IN0); K = 1024; break;
    case 1: A = (const hf*)(p->ws + OFF_H16); lda = 1024; B = (const hf*)(p->ws + W_IN1); K = 1024; break;
    case 2: A = (const hf*)(p->ws + OFF_H16); lda = 1024; B = (const hf*)(p->ws + (layer ? W_OUT1 : W_OUT0)); K = 1024; break;
    case 3: A = (const hf*)(p->ws + OFF_H16); lda = 1024; B = (const hf*)(p->ws + (layer ? W_131 : W_130)); K = 1024; break;
    case 4: A = (const hf*)(p->ws + R1_T16); lda = FH; B = (const hf*)(p->ws + (layer ? W_21 : W_20)); K = FH; break;
    default: A = (const hf*)(p->ws + R1_G16); lda = 512; B = (const hf*)(p->ws + W_GLU); K = 512; break;
  }
  const int ntn = gemm_ntn(kind);
  int mt, nt2; tile_map(t, gridDim.x, 160 * ntn, ntn, mt, nt2);
  Acc acc; zero_acc(acc);
  (void)lda; LdTiled la{A, NT, mt * 256}; LdTiled lb{B, ntn * 256, nt2 * 256};
  gemm_main(acc, la, lb, K / 32, sm, tf);
  const int row0 = mt * 256 + hb * 128;
#pragma unroll 1
  for (int pass = 0; pass < 2; ++pass) {
    acc_to_lds(acc, ct0, tf, pass);
    __syncthreads();
    const int nt = nt2 * 2 + pass;
    if (kind == 0) epi_ab(p, ct, row0, nt, tid);
    else if (kind == 1) epi_cd(p, ct, row0, nt, tid);
    else if (kind == 2) epi_res(p, ct, row0, nt, tid, layer, 2, layer == 0);
    else if (kind == 3) epi_ffn13(p, ct, row0, nt, tid);
    else if (kind == 4) epi_res(p, ct, row0, nt, tid, layer, 5, false);
    else {
      const int c16 = tid & 15;
      const hf* g16 = (const hf*)(p->ws + R1_G16); hf* o16 = (hf*)(p->ws + OFF_H16);
      const int col = nt * 128 + c16 * 8;
      float bb[8];
#pragma unroll
      for (int j = 0; j < 8; ++j) bb[j] = p->in[36][col + j];
#pragma unroll 1
      for (int ps = 0; ps < 8; ++ps) {
        const int r = ps * 16 + (tid >> 4); const int row = row0 + r;
        f4 v0 = *(const f4*)(ct + r * 132 + c16 * 8), v1 = *(const f4*)(ct + r * 132 + c16 * 8 + 4);
        const h8 g0 = *(const h8*)(g16 + tix(row, col, NT));
        h8 o;
#pragma unroll
        for (int j = 0; j < 4; ++j) { o[j] = (hf)((float)g0[j] * sigmoidf_(v0[j] + bb[j])); o[4 + j] = (hf)((float)g0[4 + j] * sigmoidf_(v1[j] + bb[4 + j])); }
        *(h8*)(o16 + tix(row, col, NT)) = o;
      }
    }
    __syncthreads();
  }
}

template <int kind>
DI void gemm_phase_reg(PP p, int layer, unsigned char* smem) {
  const int tf = opaque_tid();
  hf* sm = (hf*)smem;
  const int G = gridDim.x;
  const hf* A; const hf* B; int K;
  if (kind == 2) { A = (const hf*)(p->ws + OFF_H16); B = (const hf*)(p->ws + (layer ? W_OUT1 : W_OUT0)); K = 1024; }
  else if (kind == 3) { A = (const hf*)(p->ws + OFF_H16); B = (const hf*)(p->ws + (layer ? W_131 : W_130)); K = 1024; }
  else { A = (const hf*)(p->ws + R1_T16); B = (const hf*)(p->ws + (layer ? W_21 : W_20)); K = FH; }
  const int ntn = gemm_ntn(kind), total = 160 * ntn, nk = K / 32;
  int t = opaque_s(blockIdx.x);
  if (t >= total) return;
  int mt, nt2; tile_map(t, G, total, ntn, mt, nt2);
  LdTiled la{A, NT, mt * 256}; LdTiled lb{B, ntn * 256, nt2 * 256};
  gemm_prologue(la, lb, nk, sm, tf);
  const int w = tf >> 6, l = tf & 63, wm = w >> 1, wn = w & 1;
  while (true) {
    Acc acc; zero_acc(acc);
    gemm_loop(acc, la, lb, nk, sm, tf);
    const int cmt = mt, cnt2 = nt2;
    const int tn = t + G; const bool more = tn < total;
    if (more) {
      tile_map(tn, G, total, ntn, mt, nt2);
      la.row0 = mt * 256; lb.row0 = nt2 * 256;
      gemm_prologue(la, lb, nk, sm, tf);
    }
    if (kind == 3) {
      hf* t16 = (hf*)(p->ws + R1_T16);
      const int rbase = cmt * 256 + wm * 64 + 4 * (l >> 4);
      const int hbase = (cnt2 * 2 + wn) * 64 + (l & 15);
#pragma unroll
      for (int m = 0; m < 4; ++m) {
#pragma unroll
        for (int i = 0; i < 4; ++i) {
          hf* tp = t16 + tix(rbase + m * 16 + i, hbase, NT);
          tp[0] = (hf)(siluf_(acc.v[m][0][i]) * acc.v[m][4][i]);
          tp[16] = (hf)(siluf_(acc.v[m][1][i]) * acc.v[m][5][i]);
          tp[(size_t)NT * 32] = (hf)(siluf_(acc.v[m][2][i]) * acc.v[m][6][i]);
          tp[(size_t)NT * 32 + 16] = (hf)(siluf_(acc.v[m][3][i]) * acc.v[m][7][i]);
        }
        __builtin_amdgcn_sched_barrier(0);
      }
    }
    if (!more) break;
    t = tn;
  }
  asm volatile("s_waitcnt vmcnt(0)" ::: "memory");
  __syncthreads();
}

DI void s5_prep_item(PP p, int it, unsigned char* smem) {
  const int tf = opaque_tid(); const int half = tf >> 8; const int tid = tf & 255; smem += half * HALF_LDS; it = 2 * it + half;
  const int g = it >> 6, j = it & 63;
  float* W = (float*)smem;
  if (tid < 128) {
    const int d = tid >> 6, pp = tid & 63;
    const double lr = (double)p->in[27][(d * 32 + g) * 64 + pp], li = (double)p->in[28][(d * 32 + g) * 64 + pp];
    const double dt = exp((double)p->in[29][d * 32 + g]);
    double ar, ai; cpowd(lr, li, dt, 1, ar, ai);
    const double den = lr * lr + li * li;
    const double fr = ((ar - 1.0) * lr + ai * li) / den, fi = (ai * lr - (ar - 1.0) * li) / den;
    double xr, xi;
    cpowd(lr, li, dt, j, xr, xi);
    W[(d * 64 + pp) * 2] = (float)(xr * fr - xi * fi); W[(d * 64 + pp) * 2 + 1] = (float)(xr * fi + xi * fr);
    if (d == 0) {
      cpowd(lr, li, dt, 63 - j, xr, xi);
      W[(2 * 64 + pp) * 2] = (float)(xr * fr - xi * fi); W[(2 * 64 + pp) * 2 + 1] = (float)(xr * fi + xi * fr);
      cpowd(lr, li, dt, j + 1, xr, xi);
      W[(3 * 64 + pp) * 2] = (float)xr; W[(3 * 64 + pp) * 2 + 1] = (float)xi;
    } else {
      cpowd(lr, li, dt, 64 - j, xr, xi);
      W[(4 * 64 + pp) * 2] = (float)xr; W[(4 * 64 + pp) * 2 + 1] = (float)xi;
    }
  }
  __syncthreads();
  const float* cre = p->in[32] + (size_t)g * 1024; const float* cim = p->in[33] + (size_t)g * 1024;
  const float* bre = p->in[30] + (size_t)g * 1024; const float* bim = p->in[31] + (size_t)g * 1024;
  {
    const int co = tid >> 4, ci = tid & 15;
    float kf = 0.f, kb = 0.f;
    for (int pp = 0; pp < 64; ++pp) {
      const float cr = cre[co * 64 + pp], cm = cim[co * 64 + pp], br = bre[pp * 16 + ci], bm = bim[pp * 16 + ci];
      const float wfr = W[pp * 2], wfi = W[pp * 2 + 1], wbr = W[(64 + pp) * 2], wbi = W[(64 + pp) * 2 + 1];
      kf += (cr * wfr - cm * wfi) * br - (cr * wfi + cm * wfr) * bm;
      kb += (cr * wbr - cm * wbi) * br - (cr * wbi + cm * wbr) * bm;
    }
    hf* kc = (hf*)(p->ws + R2_KC) + (size_t)g * 127 * 256;
    if (j == 0) kc[63 * 256 + tid] = (hf)((kf + kb) * KSC);
    else { kc[(63 + j) * 256 + tid] = (hf)(kf * KSC); kc[(63 - j) * 256 + tid] = (hf)(kb * KSC); }
  }
  {
    const int pp = tid >> 2, ci0 = (tid & 3) * 4;
    hf* E = (hf*)(p->ws + R2_E) + (size_t)g * 256 * 1024;
    const float efr = W[(2 * 64 + pp) * 2], efi = W[(2 * 64 + pp) * 2 + 1], ebr = W[(64 + pp) * 2], ebi = W[(64 + pp) * 2 + 1];
    h4 o0, o1, o2, o3;
#pragma unroll
    for (int c = 0; c < 4; ++c) {
      const float br = bre[pp * 16 + ci0 + c], bm = bim[pp * 16 + ci0 + c];
      o0[c] = (hf)(efr * br - efi * bm); o1[c] = (hf)(efr * bm + efi * br);
      o2[c] = (hf)(ebr * br - ebi * bm); o3[c] = (hf)(ebr * bm + ebi * br);
    }
    *(h4*)(E + tix(0 + pp, j * 16 + ci0, 256)) = o0;
    *(h4*)(E + tix(64 + pp, j * 16 + ci0, 256)) = o1;
    *(h4*)(E + tix(128 + pp, j * 16 + ci0, 256)) = o2;
    *(h4*)(E + tix(192 + pp, j * 16 + ci0, 256)) = o3;
  }
  {
    const int co = tid >> 4, p0 = (tid & 15) * 4;
    hf* F = (hf*)(p->ws + R2_FC) + (size_t)g * 1024 * 256; const int frow = j * 16 + co;
    h4 o0, o1, o2, o3;
#pragma unroll
    for (int c = 0; c < 4; ++c) {
      const int pp = p0 + c;
      const float cr = cre[co * 64 + pp], cm = cim[co * 64 + pp];
      const float afr = W[(3 * 64 + pp) * 2], afi = W[(3 * 64 + pp) * 2 + 1], abr = W[(4 * 64 + pp) * 2], abi = W[(4 * 64 + pp) * 2 + 1];
      o0[c] = (hf)((cr * afr - cm * afi) * KSC); o1[c] = (hf)((-cr * afi - cm * afr) * KSC);
      o2[c] = (hf)((cr * abr - cm * abi) * KSC); o3[c] = (hf)((-cr * abi - cm * abr) * KSC);
    }
    *(h4*)(F + tix(frow, p0, 1024)) = o0; *(h4*)(F + tix(frow, 64 + p0, 1024)) = o1; *(h4*)(F + tix(frow, 128 + p0, 1024)) = o2; *(h4*)(F + tix(frow, 192 + p0, 1024)) = o3;
  }
  __syncthreads();
}

DI void s5_egemm_tile(PP p, int t, unsigned char* smem) {
  const int tf = opaque_tid();
  const int hb = tf >> 8, tid = tf & 255;
  hf* sm = (hf*)smem; float* ct0 = (float*)smem; const float* ct = ct0 + hb * (HALF_LDS / 4);
  const int g = t / 3, mt = t % 3;
  Acc acc; zero_acc(acc);
  LdTiled la{(const hf*)(p->ws + R1_UG) + (size_t)g * NT * 16, 640, mt * 256};
  LdTiled lb{(const hf*)(p->ws + R2_E) + (size_t)g * 256 * 1024, 256, 0};
  gemm_main(acc, la, lb, 32, sm, tf);
  const int c8 = tid & 7;
  float* Sc = (float*)(p->ws + R2_SC);
#pragma unroll 1
  for (int pass = 0; pass < 2; ++pass) {
    acc_to_lds(acc, ct0, tf, pass);
    __syncthreads();
#pragma unroll 1
    for (int ps = 0; ps < 4; ++ps) {
      const int rr = ps * 32 + (tid >> 3);
      const int n = mt * 256 + hb * 128 + rr;
      float v[16]; ld16(ct, rr, c8, v);
      if (n < 640) st16f(Sc + ((size_t)g * 640 + n) * 256 + pass * 128 + c8 * 16, v);
    }
    __syncthreads();
  }
}
DI void s5_ygemm_tile(PP p, int t, unsigned char* smem) {
  const int tf = opaque_tid();
  const int hb = tf >> 8, tid = tf & 255;
  hf* sm = (hf*)smem; float* ct0 = (float*)smem; const float* ct = ct0 + hb * (HALF_LDS / 4);
  const int g = t / 12, r = t % 12, mt = r >> 2, nt2 = r & 3;
  Acc acc; zero_acc(acc);
  {
    LdTiled la{(const hf*)(p->ws + R1_UG) + (size_t)g * NT * 16, 640, mt * 256};
    LdToep lb{(const hf*)(p->ws + R2_KC) + (size_t)g * 127 * 256, nt2 * 256};
    gemm_main(acc, la, lb, 32, sm, tf);
  }
  {
    LdTiled la{(const hf*)(p->ws + R2_H) + (size_t)g * 640 * 256, 640, mt * 256};
    LdTiled lb{(const hf*)(p->ws + R2_FC) + (size_t)g * 1024 * 256, 1024, nt2 * 256};
    gemm_main(acc, la, lb, 8, sm, tf);
  }
  const int c8 = tid & 7;
  const hf* ug = (const hf*)(p->ws + R1_UG) + (size_t)g * NT * 16;
  hf* g16 = (hf*)(p->ws + R1_G16);
  const float* dsk = p->in[34] + g * 16;
#pragma unroll 1
  for (int pass = 0; pass < 2; ++pass) {
    acc_to_lds(acc, ct0, tf, pass);
    __syncthreads();
#pragma unroll 1
    for (int ps = 0; ps < 4; ++ps) {
      const int rr = ps * 32 + (tid >> 3);
      const int n = mt * 256 + hb * 128 + rr;
      float v[16]; ld16(ct, rr, c8, v);
      if (n < 640) {
        const int tok = n * 64 + (nt2 * 2 + pass) * 8 + c8;
        const hf* up = ug + tix(tok >> 6, (tok & 63) * 16, 640);
        h8 u0 = *(const h8*)up, u1 = *(const h8*)(up + 8);
#pragma unroll
        for (int jj = 0; jj < 8; ++jj) {
          v[jj] = gelu_tanh(v[jj] * (1.f / KSC) + dsk[jj] * (float)u0[jj]);
          v[8 + jj] = gelu_tanh(v[8 + jj] * (1.f / KSC) + dsk[8 + jj] * (float)u1[jj]);
        }
        st16h(g16 + tix(tok, g * 16, NT), v);
      }
    }
    __syncthreads();
  }
}
DI void s5_scan_item(PP p, int it) {
  const int tf = opaque_tid(); const int half = tf >> 8; const int tid = tf & 255; it = 2 * it + half;
  const int gblk = it & 7, dir = (it >> 3) & 1, seq = it >> 4;
  const int g = gblk * 4 + (tid >> 6), pp = tid & 63;
  float ar, ai;
  {
    double ard, aid;
    cpowd((double)p->in[27][(dir * 32 + g) * 64 + pp], (double)p->in[28][(dir * 32 + g) * 64 + pp], exp((double)p->in[29][dir * 32 + g]), 64, ard, aid);
    ar = (float)ard; ai = (float)aid;
  }
  int n0, nch; float sr = 0.f, si = 0.f;
  if (seq < 32) { n0 = seq * 4; nch = 4; }
  else { const int b = seq - 32; n0 = 128 + b * 64; nch = 64; sr = p->in[7][((b * 2 + dir) * 32 + g) * 64 + pp]; si = p->in[8][((b * 2 + dir) * 32 + g) * 64 + pp]; }
  const float* Sc = (const float*)(p->ws + R2_SC) + (size_t)g * 640 * 256 + dir * 128 + pp;
  hf* H = (hf*)(p->ws + R2_H) + (size_t)g * 640 * 256;
#pragma unroll 4
  for (int c = 0; c < nch; ++c) {
    const int n = dir == 0 ? n0 + c : n0 + nch - 1 - c;
    const float xr = Sc[(size_t)n * 256], xi = Sc[(size_t)n * 256 + 64];
    H[tix(n, dir * 128 + pp, 640)] = (hf)sr; H[tix(n, dir * 128 + 64 + pp, 640)] = (hf)si;
    const float nr = ar * sr - ai * si + xr, ni = ar * si + ai * sr + xi;
    sr = nr; si = ni;
  }
  if (seq < 32) {
    p->out[O_SRE + ((size_t)(seq * 2 + dir) * 32 + g) * 64 + pp] = sr;
    p->out[O_SIM + ((size_t)(seq * 2 + dir) * 32 + g) * 64 + pp] = si;
  }
}

DI void attn_a_item(PP p, int it, unsigned char* smem) {
  const int tf = opaque_tid(); const int half = tf >> 8; const int tid = tf & 255; smem += half * HALF_LDS; it = 2 * it + half;
  int row0, h; KVSeg s0, s1; int qpos0 = 0;
  const hf* ka = (const hf*)(p->ws + R1_KA); const hf* va = (const hf*)(p->ws + R1_VA);
  if (it < 2048) {
    const int b = it >> 8, qb = (it >> 3) & 31; h = it & 7; const int g = h >> 2;
    row0 = NP + b * 4096 + qb * 128;
    s0.K = (const hf*)(p->ws + M_CKA) + (size_t)((b * 2 + g) * 256) * 64; s0.V = (const hf*)(p->ws + M_CVA) + (size_t)((b * 2 + g) * 256) * 64;
    s0.kld = 64; s0.vld = 64; s0.ntiles = 4; s0.kpos0 = 0;
    int ks = qb * 128 - 128, ke = qb * 128 + 256; if (ks < 0) ks = 0; if (ke > 4096) ke = 4096;
    s1.K = ka + (size_t)(NP + b * 4096 + ks) * 128 + g * 64; s1.V = va + (size_t)(NP + b * 4096 + ks) * 128 + g * 64;
    s1.kld = 128; s1.vld = 128; s1.ntiles = (ke - ks) >> 6; s1.kpos0 = ks; qpos0 = qb * 128;
  } else {
    const int t = it - 2048; const int b = t >> 4, qb = (t >> 3) & 1; h = t & 7; const int g = h >> 2;
    row0 = b * 256 + qb * 128;
    s0.K = ka + (size_t)(b * 256) * 128 + g * 64; s0.V = va + (size_t)(b * 256) * 128 + g * 64;
    s0.kld = 128; s0.vld = 128; s0.ntiles = 4; s0.kpos0 = 0;
    s1 = s0; s1.ntiles = 0;
  }
  f16v O[2];
  const float sink = p->in[22][h] * LOG2E;
  attn_run<64>(O, (const hf*)(p->ws + R1_QA) + (size_t)row0 * 512 + h * 64, 512, s0, s1, sink, 1.f, qpos0, true, (hf*)smem, tid);
  const int w = tid >> 6, l = tid & 63, lr32 = l & 31, hh = l >> 5;
  hf* o16 = (hf*)(p->ws + OFF_H16);
  const int orow = row0 + w * 32 + lr32;
#pragma unroll
  for (int d = 0; d < 2; ++d)
#pragma unroll
    for (int gq = 0; gq < 4; ++gq) {
      h4 o; o[0] = (hf)O[d][4 * gq]; o[1] = (hf)O[d][4 * gq + 1]; o[2] = (hf)O[d][4 * gq + 2]; o[3] = (hf)O[d][4 * gq + 3];
      *(h4*)(o16 + tix(orow, h * 64 + d * 32 + 8 * gq + 4 * hh, NT)) = o;
    }
}

DI void attn_d_item(PP p, int it, unsigned char* smem) {
  const int tf = opaque_tid(); const int half = tf >> 8; const int tid = tf & 255; smem += half * HALF_LDS; it = 2 * it + half;
  const hf* kd = (const hf*)(p->ws + R1_KD); const hf* vd = (const hf*)(p->ws + R1_VD);
  int row0, h, b; bool sample;
  if (it < 1024) { b = it >> 7; const int qb = (it >> 2) & 31; h = it & 3; row0 = NP + b * 4096 + qb * 128; sample = true; }
  else { const int t = it - 1024; b = t >> 3; const int qb = (t >> 2) & 1; h = t & 3; row0 = b * 256 + qb * 128; sample = false; }
  const float lam = ((const float*)(p->ws + M_SCAL))[0];
  const int w = tid >> 6, l = tid & 63, lr32 = l & 31, hh = l >> 5;
  hf* o16 = (hf*)(p->ws + OFF_H16);
  const int orow = row0 + w * 32 + lr32, ocol = 512 + h * 128;
  f16v O[4];
#pragma unroll 1
  for (int c = 0; c < 2; ++c) {
    KVSeg s0, s1;
    if (sample) {
      s0.K = (const hf*)(p->ws + M_CKD) + (size_t)(((b * 4 + h) * 2 + c) * 256) * 64; s0.V = (const hf*)(p->ws + M_CVD) + (size_t)((b * 4 + h) * 256) * 128;
      s0.kld = 64; s0.vld = 128; s0.ntiles = 4; s0.kpos0 = 0;
      s1.K = kd + (size_t)(NP + b * 4096) * 512 + h * 128 + c * 64; s1.V = vd + (size_t)(NP + b * 4096) * 512 + h * 128;
      s1.kld = 512; s1.vld = 512; s1.ntiles = 64; s1.kpos0 = 0;
    } else {
      s0.K = kd + (size_t)(b * 256) * 512 + h * 128 + c * 64; s0.V = vd + (size_t)(b * 256) * 512 + h * 128;
      s0.kld = 512; s0.vld = 512; s0.ntiles = 4; s0.kpos0 = 0;
      s1 = s0; s1.ntiles = 0;
    }
    attn_run<128>(O, (const hf*)(p->ws + R1_QD) + (size_t)row0 * 512 + h * 128 + c * 64, 512, s0, s1, NEGBIG, 0.f, 0, false, (hf*)smem, tid);
    if (c == 0) {
#pragma unroll
      for (int d = 0; d < 4; ++d)
#pragma unroll
        for (int gq = 0; gq < 4; ++gq) {
          h4 o; o[0] = (hf)O[d][4 * gq]; o[1] = (hf)O[d][4 * gq + 1]; o[2] = (hf)O[d][4 * gq + 2]; o[3] = (hf)O[d][4 * gq + 3];
          *(h4*)(o16 + tix(orow, ocol + d * 32 + 8 * gq + 4 * hh, NT)) = o;
        }
    }
  }
  float ss = 0.f;
#pragma unroll
  for (int d = 0; d < 4; ++d)
#pragma unroll
    for (int gq = 0; gq < 4; ++gq) {
      h4 o0 = *(const h4*)(o16 + tix(orow, ocol + d * 32 + 8 * gq + 4 * hh, NT));
#pragma unroll
      for (int r = 0; r < 4; ++r) { float x = (float)o0[r] - lam * O[d][4 * gq + r]; O[d][4 * gq + r] = x; ss += x * x; }
    }
  ss += __shfl_xor(ss, 32);
  const float rstd = rsqrtf(ss * (1.f / 128.f) + 1e-6f) * (1.f - 0.35550906759096994f);
  const float* sg = p->in[40];
#pragma unroll
  for (int d = 0; d < 4; ++d)
#pragma unroll
    for (int gq = 0; gq < 4; ++gq) {
      const int dv0 = d * 32 + 8 * gq + 4 * hh;
      h4 o;
#pragma unroll
      for (int r = 0; r < 4; ++r) o[r] = (hf)(O[d][4 * gq + r] * rstd * sg[dv0 + r]);
      *(h4*)(o16 + tix(orow, ocol + dv0, NT)) = o;
    }
}

DI void ret_kv_item(PP p, int it, unsigned char* smem) {
  const int tf = opaque_tid(); const int half = tf >> 8; const int tid = tf & 255; smem += half * HALF_LDS; it = 2 * it + half;
  const int cg_ = it >> 3, h = it & 7;
  const float* lgt = (const float*)(p->ws + M_SCAL) + 16;
  const float lgf2 = lgt[h] * LOG2E, lgb2 = lgt[8 + h] * LOG2E;
  hf* sKf = (hf*)smem; hf* sKb = sKf + 128 * 72; hf* sV = sKb + 128 * 72;
  const hf* kb = (const hf*)(p->ws + R1_KB) + (size_t)cg_ * 128 * 512 + h * 64;
  const hf* vb = (const hf*)(p->ws + R1_VB) + (size_t)cg_ * 128 * 512 + h * 64;
  const int kr = tid >> 3, kc = (tid & 7) * 8;
#pragma unroll
  for (int i = 0; i < 4; ++i) {
    const int r = kr + 32 * i;
    h8 kv = *(const h8*)(kb + (size_t)r * 512 + kc), vv = *(const h8*)(vb + (size_t)r * 512 + kc);
    const hf df = (hf)ex2(lgf2 * (float)(127 - r)), db = (hf)ex2(lgb2 * (float)r);
    h8 kf, kbv;
#pragma unroll
    for (int j = 0; j < 8; ++j) { kf[j] = kv[j] * df; kbv[j] = kv[j] * db; }
    *(h8*)(sKf + r * 72 + kc) = kf; *(h8*)(sKb + r * 72 + kc) = kbv; *(h8*)(sV + r * 72 + kc) = vv;
  }
  __syncthreads();
  const int w = tid >> 6, l = tid & 63, lr32 = l & 31, hh = l >> 5;
  const int dir = w >> 1, dvb = w & 1;
  const hf* sKx = dir ? sKb : sKf;
  const int i16 = l & 15, q4 = i16 >> 2, p4 = i16 & 3, blk = (l >> 4) & 1;
  const int toff = (8 * hh + q4) * 72 + 16 * blk + 4 * p4;
  f16v acc[2]; acc[0] = zero16(); acc[1] = zero16();
#pragma unroll
  for (int k0 = 0; k0 < 8; ++k0) {
    const hf* vp = sV + k0 * 16 * 72 + toff + dvb * 32;
    h8 af = cat8(trread(vp), trread(vp + 4 * 72));
#pragma unroll
    for (int dkb = 0; dkb < 2; ++dkb) {
      const hf* kp = sKx + k0 * 16 * 72 + toff + dkb * 32;
      h8 bf = cat8(trread(kp), trread(kp + 4 * 72));
      acc[dkb] = MFMA(af, bf, acc[dkb]);
    }
  }
  float* kvc = (float*)(p->ws + R2_KVC) + ((size_t)(cg_ * 8 + h) * 2 + dir) * 4096;
#pragma unroll
  for (int dkb = 0; dkb < 2; ++dkb)
#pragma unroll
    for (int e = 0; e < 16; ++e) kvc[(dvb * 32 + crow(e, hh)) * 64 + dkb * 32 + lr32] = acc[dkb][e];
  __syncthreads();
}

DI void ret_scan_item(PP p, int it, unsigned char* smem) {
  const int tf = opaque_tid(); const int half = tf >> 8; const int tid = tf & 255; smem += half * HALF_LDS; it = 2 * it + half;
  const int dir = it & 1, h = (it >> 1) & 7, seq = it >> 4;
  const float lg = ((const float*)(p->ws + M_SCAL))[16 + dir * 8 + h];
  const float cd = __expf(lg * 128.f);
  int c0, nch; float st[16];
  if (seq < 32) {
    c0 = seq * 2; nch = 2;
#pragma unroll
    for (int i = 0; i < 16; ++i) st[i] = 0.f;
  } else {
    const int b = seq - 32; c0 = 64 + b * 32; nch = 32;
    const float* s0 = p->in[6] + ((size_t)(b * 2 + dir) * 8 + h) * 4096;
#pragma unroll
    for (int i = 0; i < 16; ++i) { const int e = tid + 256 * i; st[i] = s0[(e & 63) * 64 + (e >> 6)]; }
  }
  const float* kvc = (const float*)(p->ws + R2_KVC);
  hf* stt = (hf*)(p->ws + R2_STT);
#pragma unroll 1
  for (int c = 0; c < nch; ++c) {
    const int cgi = dir == 0 ? c0 + c : c0 + nch - 1 - c;
    const size_t base = ((size_t)(cgi * 8 + h) * 2 + dir) * 4096;
#pragma unroll
    for (int i = 0; i < 16; ++i) { const int e = tid + 256 * i; stt[base + e] = (hf)st[i]; st[i] = cd * st[i] + kvc[base + e]; }
  }
  if (seq < 32) {
    float* tile = (float*)smem;
#pragma unroll
    for (int i = 0; i < 16; ++i) { const int e = tid + 256 * i; tile[(e >> 6) * 65 + (e & 63)] = st[i]; }
    __syncthreads();
    float* o = p->out + O_RET + ((size_t)(seq * 2 + dir) * 8 + h) * 4096;
#pragma unroll
    for (int i = 0; i < 16; ++i) { const int e = tid + 256 * i; o[e] = tile[(e & 63) * 65 + (e >> 6)]; }
    __syncthreads();
  }
}

DI void ret_out_item(PP p, int it, unsigned char* smem) {
  const int tf = opaque_tid(); const int half = tf >> 8; const int tid = tf & 255; smem += half * HALF_LDS; it = 2 * it + half;
  const int cg_ = it >> 3, h = it & 7;
  const float* lgt = (const float*)(p->ws + M_SCAL) + 16;
  const float lgf2 = lgt[h] * LOG2E, lgb2 = lgt[8 + h] * LOG2E;
  hf* sK = (hf*)smem; hf* sV = sK + 128 * 72;
  const int row0 = cg_ * 128;
  const hf* kb = (const hf*)(p->ws + R1_KB) + (size_t)row0 * 512 + h * 64;
  const hf* vb = (const hf*)(p->ws + R1_VB) + (size_t)row0 * 512 + h * 64;
  const int kr = tid >> 3, kc = (tid & 7) * 8;
#pragma unroll
  for (int i = 0; i < 4; ++i) {
    const int r = kr + 32 * i;
    *(h8*)(sK + r * 72 + kc) = *(const h8*)(kb + (size_t)r * 512 + kc);
    *(h8*)(sV + r * 96 + kc) = *(const h8*)(vb + (size_t)r * 512 + kc);
  }
  const int w = tid >> 6, l = tid & 63, lr32 = l & 31, hh = l >> 5;
  h8 qf[4];
  {
    const hf* qp = (const hf*)(p->ws + R1_QB) + (size_t)(row0 + w * 32 + lr32) * 512 + h * 64 + 8 * hh;
#pragma unroll
    for (int ks = 0; ks < 4; ++ks) qf[ks] = *(const h8*)(qp + ks * 16);
  }
  __syncthreads();
  const int i16 = l & 15, q4 = i16 >> 2, p4 = i16 & 3, blk = (l >> 4) & 1;
  const int voff = (4 * hh + q4) * 96 + 16 * blk + 4 * p4;
  const int iq = w * 32 + lr32;
  f16v O[2]; O[0] = zero16(); O[1] = zero16();
#pragma unroll 1
  for (int kbk = 0; kbk < 4; ++kbk) {
    f16v st = zero16();
    const hf* kp = sK + (kbk * 32 + lr32) * 72 + 8 * hh;
#pragma unroll
    for (int ks = 0; ks < 4; ++ks) { h8 kf = *(const h8*)(kp + ks * 16); st = MFMA(kf, qf[ks], st); }
#pragma unroll
    for (int e = 0; e < 16; ++e) {
      const int j = kbk * 32 + crow(e, hh); const int d = iq - j;
      const float dec = d > 0 ? ex2(lgf2 * (float)d) : (d < 0 ? ex2(lgb2 * (float)(-d)) : 2.f);
      st[e] *= dec;
    }
#pragma unroll
    for (int s = 0; s < 2; ++s) {
      const h8 pf = pack8(st, s);
      const hf* vp = sV + (kbk * 32 + 16 * s) * 96 + voff;
#pragma unroll
      for (int d = 0; d < 2; ++d) { h8 vf = cat8(trread(vp + d * 32), trread(vp + 8 * 96 + d * 32)); O[d] = MFMA(vf, pf, O[d]); }
    }
  }
  const hf* stt = (const hf*)(p->ws + R2_STT) + (size_t)(cg_ * 8 + h) * 2 * 4096;
  f16v cf[2], cb[2];
#pragma unroll
  for (int d = 0; d < 2; ++d) {
    cf[d] = zero16(); cb[d] = zero16();
#pragma unroll
    for (int ks = 0; ks < 4; ++ks) {
      h8 af = *(const h8*)(stt + (d * 32 + lr32) * 64 + ks * 16 + 8 * hh);
      h8 ab = *(const h8*)(stt + 4096 + (d * 32 + lr32) * 64 + ks * 16 + 8 * hh);
      cf[d] = MFMA(af, qf[ks], cf[d]); cb[d] = MFMA(ab, qf[ks], cb[d]);
    }
  }
  const float qsf = ex2(lgf2 * (float)(iq + 1)), qsb = ex2(lgb2 * (float)(128 - iq));
  float ss = 0.f;
#pragma unroll
  for (int d = 0; d < 2; ++d)
#pragma unroll
    for (int e = 0; e < 16; ++e) { float x = O[d][e] + qsf * cf[d][e] + qsb * cb[d][e]; O[d][e] = x; ss += x * x; }
  ss += __shfl_xor(ss, 32);
  const float rstd = rsqrtf(ss * (1.f / 64.f) + 1e-6f);
  const int row = row0 + iq;
  const hf* gb = (const hf*)(p->ws + R1_GB) + (size_t)row * 512 + h * 64;
  hf* o16 = (hf*)(p->ws + OFF_H16);
  const float* rg = p->in[24];
#pragma unroll
  for (int d = 0; d < 2; ++d)
#pragma unroll
    for (int gq = 0; gq < 4; ++gq) {
      const int dv0 = d * 32 + 8 * gq + 4 * hh;
      h4 gv = *(const h4*)(gb + dv0);
      h4 o;
#pragma unroll
      for (int r = 0; r < 4; ++r) o[r] = (hf)(O[d][4 * gq + r] * rstd * rg[dv0 + r] * siluf_((float)gv[r]));
      *(h4*)(o16 + tix(row, 512 + h * 64 + dv0, NT)) = o;
    }
  __syncthreads();
}


#define XB_TMO      128
#define XB_XCNT(j)  (256  + 64 * (j))
#define XB_XSUB(j)  (1280 + 64 * (j))
#define XB_XGEN(j)  (2304 + 64 * (j))
#define XB_TOP      3328
#define XB_TOPGEN   3392
#define XCD_BAR_WORDS 3456
#define XB_SPIN_CAP (1u << 18)
#define LAS __attribute__((address_space(3)))
DI unsigned xb_ld(unsigned* p) { return __hip_atomic_load(p, __ATOMIC_RELAXED, __HIP_MEMORY_SCOPE_AGENT); }
DI unsigned xb_add(unsigned* p, unsigned v) { return __hip_atomic_fetch_add(p, v, __ATOMIC_RELAXED, __HIP_MEMORY_SCOPE_AGENT); }
DI unsigned xb_xcc_id() { return (unsigned)__builtin_amdgcn_s_getreg((3 << 11) | 20) & 0xFu; }
#define XB_SPIN(cond, bar) do { unsigned _sp = 0; while (cond) { __builtin_amdgcn_s_sleep(1); \
    if ((++_sp & 255u) == 0u) { if (xb_ld(&(bar)[XB_TMO])) break; if (_sp > XB_SPIN_CAP) { atomicAdd(&(bar)[XB_TMO], 1u); break; } } } } while (0)
struct XcdBarrier { unsigned* bar; unsigned x; volatile LAS unsigned* st; };
DI XcdBarrier xcd_barrier_post(unsigned* bar, volatile LAS unsigned* st) {
  XcdBarrier b; b.bar = bar; b.x = xb_xcc_id(); b.st = st;
  if (threadIdx.x == 0) (void)xb_add(&bar[XB_XCNT(b.x)], 1u);
  return b;
}
DI void xcd_barrier_complete(unsigned* bar, unsigned x, unsigned& nloc, unsigned& nx) {
  const unsigned G = gridDim.x * gridDim.y * gridDim.z;
  unsigned sum, cnt, mine, sp = 0u;
  for (;;) {
    sum = 0u; cnt = 0u; mine = 0u;
#pragma unroll
    for (unsigned j = 0; j < 16; ++j) { const unsigned c = xb_ld(&bar[XB_XCNT(j)]); sum += c; cnt += (c > 0u) ? 1u : 0u; mine = (j == x) ? c : mine; }
    if (sum == G) break;
    __builtin_amdgcn_s_sleep(1);
    if ((++sp & 255u) == 0u) { if (xb_ld(&bar[XB_TMO])) break; if (sp > XB_SPIN_CAP) { atomicAdd(&bar[XB_TMO], 1u); break; } }
  }
  nloc = mine > 0u ? mine : 1u; nx = cnt > 0u ? cnt : 1u;
}
DI void xcd_barrier(const XcdBarrier& b) {
  asm volatile("s_waitcnt vmcnt(0)" ::: "memory");
  __syncthreads();
  if (threadIdx.x == 0) {
    unsigned* bar = b.bar;
    __builtin_amdgcn_s_waitcnt(0);
    unsigned nloc = b.st[0], nx = b.st[1];
    if (nloc == 0u) { xcd_barrier_complete(bar, b.x, nloc, nx); b.st[0] = nloc; b.st[1] = nx; }
    const unsigned old = xb_add(&bar[XB_XSUB(b.x)], 1u);
    const unsigned gen = old / nloc;
    if (old + 1u == (gen + 1u) * nloc) {
      __builtin_amdgcn_fence(__ATOMIC_RELEASE, "agent");
      asm volatile("s_waitcnt vmcnt(0)" ::: "memory");
      const unsigned og = xb_add(&bar[XB_TOP], 1u);
      const unsigned tg = og / nx;
      if (og + 1u == (tg + 1u) * nx) xb_add(&bar[XB_TOPGEN], 1u);
      else XB_SPIN(xb_ld(&bar[XB_TOPGEN]) == tg, bar);
      __builtin_amdgcn_fence(__ATOMIC_ACQUIRE, "agent");
      xb_add(&bar[XB_XGEN(b.x)], 1u);
      asm volatile("s_waitcnt vmcnt(0)" ::: "memory");
    } else {
      XB_SPIN(xb_ld(&bar[XB_XGEN(b.x)]) == gen, bar);
      __builtin_amdgcn_fence(__ATOMIC_ACQUIRE, "agent");
      asm volatile("s_waitcnt vmcnt(0)" ::: "memory");
    }
  }
  __syncthreads();
}

constexpr int NPHASE = 20;

template <int ph>
DI void run_phase(PP p0, unsigned char* smem) {
  PP p = opaque_p(p0);
  const int G = opaque_s(gridDim.x), bid = opaque_s(blockIdx.x);
  if constexpr (ph == 0) phase_prep(p, smem);
  else if constexpr (ph == 1) phase_norm(p, 0, 0);
  else if constexpr (ph == 2) { for (int t = bid; t < 160 * 11; t += G) gemm_tile_std(p, 0, 0, t, smem); }
  else if constexpr (ph == 3) { for (int t = bid; t < 1280 + 1280; t += G) { if (t < 1280) attn_a_item(p, t, smem); else ret_kv_item(p, t - 1280, smem); } }
  else if constexpr (ph == 4) { for (int t = bid; t < 320; t += G) ret_scan_item(p, 319 - t, smem); }
  else if constexpr (ph == 5) { for (int t = bid; t < 1280; t += G) ret_out_item(p, t, smem); }
  else if constexpr (ph == 6) { for (int t = bid; t < 160 * 4; t += G) gemm_tile_std(p, 2, 0, t, smem); }
  else if constexpr (ph == 7) phase_norm(p, 0, 1);
  else if constexpr (ph == 8) gemm_phase_reg<3>(p, 0, smem);
  else if constexpr (ph == 9) {
    for (int t = bid; t < 160 * 4; t += G) gemm_tile_std(p, 4, 0, t, smem);
    if (bid >= (G >> 1)) { for (int t = bid - (G >> 1); t < 1024; t += G - (G >> 1)) s5_prep_item(p, t, smem); }
  }
  else if constexpr (ph == 10) phase_norm(p, 1, 0);
  else if constexpr (ph == 11) { for (int t = bid; t < 160 * 8; t += G) gemm_tile_std(p, 1, 1, t, smem); }
  else if constexpr (ph == 12) { for (int t = bid; t < 640 + 96; t += G) { if (t < 640) attn_d_item(p, t, smem); else s5_egemm_tile(p, t - 640, smem); } }
  else if constexpr (ph == 13) { for (int t = bid; t < 320; t += G) s5_scan_item(p, 319 - t); }
  else if constexpr (ph == 14) { for (int t = bid; t < 384; t += G) s5_ygemm_tile(p, t, smem); }
  else if constexpr (ph == 15) { for (int t = bid; t < 160 * 2; t += G) gemm_tile_std(p, 5, 1, t, smem); }
  else if constexpr (ph == 16) { for (int t = bid; t < 160 * 4; t += G) gemm_tile_std(p, 2, 1, t, smem); }
  else if constexpr (ph == 17) phase_norm(p, 1, 1);
  else if constexpr (ph == 18) gemm_phase_reg<3>(p, 1, smem);
  else { for (int t = bid; t < 160 * 4; t += G) gemm_tile_std(p, 4, 1, t, smem); }
}

#ifndef REPEAT_MASK
#define REPEAT_MASK 0u
#endif
template <int ph>
DI void do_phase(PP p, int ph_lo, int ph_hi, unsigned char* smem, cg::grid_group& grid, const XcdBarrier& xb) {
  if (ph_lo <= ph && ph < ph_hi) {
    run_phase<ph>(p, smem);
    if constexpr (((REPEAT_MASK >> ph) & 1u) != 0u) { grid.sync(); run_phase<ph>(p, smem); }
    if (ph + 1 < ph_hi) {
      if (ph_lo < 0) grid.sync();
      xcd_barrier(xb);
    }
  }
}

__global__ void __launch_bounds__(512) mega(P p_arg, int ph_lo, int ph_hi) {
  extern __shared__ __attribute__((aligned(16))) unsigned char smem[];
  PP p = (PP)__builtin_amdgcn_kernarg_segment_ptr();
  cg::grid_group grid = cg::this_grid();
  if ((threadIdx.x >> 6) >= 4) __builtin_amdgcn_s_setprio(1);
  volatile LAS unsigned* st = (volatile LAS unsigned*)(smem + LDS_BYTES);
  if (threadIdx.x < 2) st[threadIdx.x] = 0u;
  __syncthreads();
  const XcdBarrier xb = xcd_barrier_post((unsigned*)(p->ws + M_BAR), st);
  do_phase<0>(p, ph_lo, ph_hi, smem, grid, xb);
  do_phase<1>(p, ph_lo, ph_hi, smem, grid, xb);
  do_phase<2>(p, ph_lo, ph_hi, smem, grid, xb);
  do_phase<3>(p, ph_lo, ph_hi, smem, grid, xb);
  do_phase<4>(p, ph_lo, ph_hi, smem, grid, xb);
  do_phase<5>(p, ph_lo, ph_hi, smem, grid, xb);
  do_phase<6>(p, ph_lo, ph_hi, smem, grid, xb);
  do_phase<7>(p, ph_lo, ph_hi, smem, grid, xb);
  do_phase<8>(p, ph_lo, ph_hi, smem, grid, xb);
  do_phase<9>(p, ph_lo, ph_hi, smem, grid, xb);
  do_phase<10>(p, ph_lo, ph_hi, smem, grid, xb);
  do_phase<11>(p, ph_lo, ph_hi, smem, grid, xb);
  do_phase<12>(p, ph_lo, ph_hi, smem, grid, xb);
  do_phase<13>(p, ph_lo, ph_hi, smem, grid, xb);
  do_phase<14>(p, ph_lo, ph_hi, smem, grid, xb);
  do_phase<15>(p, ph_lo, ph_hi, smem, grid, xb);
  do_phase<16>(p, ph_lo, ph_hi, smem, grid, xb);
  do_phase<17>(p, ph_lo, ph_hi, smem, grid, xb);
  do_phase<18>(p, ph_lo, ph_hi, smem, grid, xb);
  do_phase<19>(p, ph_lo, ph_hi, smem, grid, xb);
}

#ifndef N_LAUNCH_PER_PHASE
#define N_LAUNCH_PER_PHASE 0
#endif

extern "C" void kernel_launch(void* const* d_in, const int* in_sizes, int n_in, void* d_out, int out_size, void* d_ws, size_t ws_size, hipStream_t stream) {
  constexpr size_t kDynLds = LDS_BYTES + 16;
  static int grid_blocks = 0;
  if (!grid_blocks) {
    int dev = 0, cus = 0, per_cu = 0;
    (void)hipGetDevice(&dev);
    (void)hipDeviceGetAttribute(&cus, hipDeviceAttributeMultiprocessorCount, dev);
    (void)hipFuncSetAttribute((const void*)mega, hipFuncAttributeMaxDynamicSharedMemorySize, (int)kDynLds);
    (void)hipOccupancyMaxActiveBlocksPerMultiprocessor(&per_cu, mega, NTHR, kDynLds);
    if (per_cu > 1) per_cu = 1;
    if (per_cu < 1) per_cu = 1;
    grid_blocks = cus * per_cu;
    if (ws_size < WS_END || n_in != 41) fprintf(stderr, "kernel_launch: unexpected ws_size %zu (need %zu) or n_in %d\n", ws_size, (size_t)WS_END, n_in);
  }
  (void)hipMemsetAsync((unsigned char*)d_ws + M_BAR, 0, XCD_BAR_WORDS * sizeof(unsigned), stream);
  P p{};
  for (int i = 0; i < 41; ++i) p.in[i] = (const float*)d_in[i];
  p.out = (float*)d_out; p.ws = (unsigned char*)d_ws;
#if N_LAUNCH_PER_PHASE
  for (int ph = 0; ph < NPHASE; ++ph) hipLaunchKernelGGL(mega, dim3(grid_blocks), dim3(NTHR), kDynLds, stream, p, ph, ph + 1);
#else
  int lo = 0, hi = NPHASE;
  void* args[] = {&p, &lo, &hi};
  hipError_t e = hipLaunchCooperativeKernel((void*)mega, dim3(grid_blocks), dim3(NTHR), args, kDynLds, stream);
  if (e != hipSuccess) fprintf(stderr, "cooperative launch failed: %s (grid %d)\n", hipGetErrorString(e), grid_blocks);
#endif
}
```
